# Optimizing an MI355X kernel written in HIP

```python
import math
import jax
import jax.numpy as jnp
from jax import lax
import numpy as np


D_MODEL = 1024
BATCH = 2
SEQ = 8192
DEPTH = 2

GRID_W = 64
CTX_LEN = 256
HEAD_DIM = 64
N_BRANCH = 4
BRANCH_W = 512
Q_BLOCK = 128
ROPE_BASE = 10000.0
EPS = 1e-6
NEG = -1e30

WIN_HEADS = 8
WIN_KV_HEADS = 2
WIN_RADIUS = 128
WIN_BLOCK = 128
DIF_HEADS = 4
DIF_QK_DIM = 64
DIF_V_DIM = 128
NAT_HEADS = 8
NAT_WIN_ROWS = 8
NAT_WIN_COLS = 16
MLA_HEADS = 8
MLA_NOPE = 64
MLA_ROPE = 32
MLA_V = 64
MLA_Q_LORA = 256
MLA_KV_LORA = 128
N_EXPERTS = 16
N_GROUPS = 4
TOP_K = 2
D_EXPERT = 512
MOE_BLOCK = 256

IN_SIZES = (WIN_HEADS * HEAD_DIM, WIN_KV_HEADS * HEAD_DIM, WIN_KV_HEADS * HEAD_DIM,
            DIF_HEADS * 2 * DIF_QK_DIM, DIF_HEADS * 2 * DIF_QK_DIM, DIF_HEADS * DIF_V_DIM,
            NAT_HEADS * HEAD_DIM, NAT_HEADS * HEAD_DIM, NAT_HEADS * HEAD_DIM,
            MLA_Q_LORA, MLA_KV_LORA + MLA_ROPE, N_BRANCH * D_MODEL)
D_IN = sum(IN_SIZES)

kernel_name = 'hybrid_gated_mixers_grouped_moe_diffusion_block'


def rms_norm(x, g):
    xf = x.astype(jnp.float32)
    y = xf * lax.rsqrt(jnp.mean(xf * xf, axis=-1, keepdims=True) + EPS)
    return (y * g.astype(jnp.float32)).astype(x.dtype)


def rope_cos_sin(n_tok, dim, dtype):
    t = jnp.arange(n_tok)
    rows = (t // GRID_W).astype(jnp.float32)
    cols = (t % GRID_W).astype(jnp.float32)
    quarter = dim // 4
    inv_freq = jnp.exp(-math.log(ROPE_BASE) * jnp.arange(quarter, dtype=jnp.float32) / quarter)
    ang = jnp.concatenate([rows[:, None] * inv_freq, cols[:, None] * inv_freq], axis=-1)
    return jnp.cos(ang).astype(dtype), jnp.sin(ang).astype(dtype)


def apply_rope(x, cos, sin):
    half = x.shape[-1] // 2
    x1, x2 = x[..., :half], x[..., half:]
    c = cos[:, None, :]
    s = sin[:, None, :]
    return jnp.concatenate([x1 * c - x2 * s, x1 * s + x2 * c], axis=-1)


def joint_softmax(parts):
    m = parts[0].max(axis=-1, keepdims=True)
    for p in parts[1:]:
        m = jnp.maximum(m, p.max(axis=-1, keepdims=True))
    ex = [jnp.exp(p - m) for p in parts]
    z = ex[0].sum(axis=-1, keepdims=True)
    for e in ex[1:]:
        z = z + e.sum(axis=-1, keepdims=True)
    return [e / z for e in ex]


def sweep_query_blocks(fn, q):
    b, t = q.shape[:2]
    nb = t // Q_BLOCK
    qb = jnp.moveaxis(q.reshape((b, nb, Q_BLOCK) + q.shape[2:]), 1, 0)
    out = lax.map(fn, qb)
    return jnp.moveaxis(out, 0, 1).reshape((b, t) + out.shape[3:])


def flat_heads(y):
    return y.reshape(y.shape[0], y.shape[1], -1)


def dense_attention(q, k, v):
    scale = q.shape[-1] ** -0.5

    def block(qb):
        logits = jnp.einsum('bqhd,bkhd->bhqk', qb, k).astype(jnp.float32) * scale
        p = jax.nn.softmax(logits, axis=-1)
        return jnp.einsum('bhqk,bkhd->bqhd', p.astype(v.dtype), v)

    return sweep_query_blocks(block, q)


def diff_attention(q, k, v, lam):
    scale = q.shape[-1] ** -0.5

    def block(qb):
        logits = jnp.einsum('bqhid,bkhid->bhiqk', qb, k).astype(jnp.float32) * scale
        p = jax.nn.softmax(logits, axis=-1)
        a = p[:, :, 0] - lam * p[:, :, 1]
        return jnp.einsum('bhqk,bkhd->bqhd', a.astype(v.dtype), v)

    return sweep_query_blocks(block, q)


def window_attention(q, k, v, kc, vc, sink):
    b, s, _, hd = q.shape
    g = WIN_HEADS // WIN_KV_HEADS
    nb = s // WIN_BLOCK
    scale = hd ** -0.5
    qb = q.reshape(b, nb, WIN_BLOCK, WIN_KV_HEADS, g, hd)

    def band(t):
        tp = jnp.pad(t, ((0, 0), (WIN_BLOCK, WIN_BLOCK), (0, 0), (0, 0)))
        tp = tp.reshape(b, nb + 2, WIN_BLOCK, WIN_KV_HEADS, hd)
        return jnp.concatenate([tp[:, :-2], tp[:, 1:-1], tp[:, 2:]], axis=2)

    kb, vb = band(k), band(v)
    qi = jnp.arange(WIN_BLOCK)
    kj = jnp.arange(3 * WIN_BLOCK)
    rel = kj[None, :] - WIN_BLOCK - qi[:, None]
    key_pos = (jnp.arange(nb)[:, None] - 1) * WIN_BLOCK + kj[None, :]
    valid = (jnp.abs(rel) <= WIN_RADIUS)[None] & ((key_pos >= 0) & (key_pos < s))[:, None, :]
    s_band = jnp.einsum('bnqkgd,bnjkd->bnkgqj', qb, kb).astype(jnp.float32) * scale
    s_band = jnp.where(valid[None, :, None, None], s_band, NEG)
    s_ctx = jnp.einsum('bnqkgd,bckd->bnkgqc', qb, kc).astype(jnp.float32) * scale
    s_sink = jnp.broadcast_to(sink.astype(jnp.float32).reshape(1, 1, WIN_KV_HEADS, g, 1, 1),
                              s_ctx.shape[:-1] + (1,))
    p_band, p_ctx, _ = joint_softmax([s_band, s_ctx, s_sink])
    out = (jnp.einsum('bnkgqj,bnjkd->bnqkgd', p_band.astype(v.dtype), vb)
           + jnp.einsum('bnkgqc,bckd->bnqkgd', p_ctx.astype(v.dtype), vc))
    return out.reshape(b, s, WIN_HEADS * hd)


def window_attention_context(qc, kc, vc, sink):
    b, n, _, hd = qc.shape
    g = WIN_HEADS // WIN_KV_HEADS
    scale = hd ** -0.5
    qg = qc.reshape(b, n, WIN_KV_HEADS, g, hd)
    sc = jnp.einsum('bqkgd,bckd->bkgqc', qg, kc).astype(jnp.float32) * scale
    s_sink = jnp.broadcast_to(sink.astype(jnp.float32).reshape(1, WIN_KV_HEADS, g, 1, 1), sc.shape[:-1] + (1,))
    p, _ = joint_softmax([sc, s_sink])
    out = jnp.einsum('bkgqc,bckd->bqkgd', p.astype(vc.dtype), vc)
    return out.reshape(b, n, WIN_HEADS * hd)


def neighbourhood_attention(q, k, v, kc, vc, rpb):
    b, s, h, hd = q.shape
    rows = s // GRID_W
    wr = min(NAT_WIN_ROWS, rows)
    wc = NAT_WIN_COLS
    scale = hd ** -0.5
    r = jnp.arange(rows)
    row_idx = jnp.clip(r - wr // 2, 0, rows - wr)[:, None] + jnp.arange(wr)[None, :]
    col = jnp.arange(GRID_W)
    col_start = jnp.clip(col - wc // 2, 0, GRID_W - wc)
    col_ok = (col[None, :] >= col_start[:, None]) & (col[None, :] < col_start[:, None] + wc)
    qg = q.reshape(b, rows, GRID_W, h, hd)
    kg = k.reshape(b, rows, GRID_W, h, hd)[:, row_idx]
    vg = v.reshape(b, rows, GRID_W, h, hd)[:, row_idx]
    d_row = row_idx - r[:, None] + (NAT_WIN_ROWS - 1)
    d_col = jnp.clip(col[None, :] - col[:, None] + (wc - 1), 0, 2 * wc - 2)
    bias = rpb[:, d_row[:, None, :, None], d_col[None, :, None, :]].astype(jnp.float32)
    s_nb = jnp.einsum('brqhd,brakhd->bhrqak', qg, kg).astype(jnp.float32) * scale + bias[None]
    s_nb = jnp.where(col_ok[:, None, :], s_nb, NEG).reshape(b, h, rows, GRID_W, wr * GRID_W)
    s_cx = jnp.einsum('brqhd,bchd->bhrqc', qg, kc).astype(jnp.float32) * scale
    p_nb, p_cx = joint_softmax([s_nb, s_cx])
    p_nb = p_nb.reshape(b, h, rows, GRID_W, wr, GRID_W).astype(v.dtype)
    out = (jnp.einsum('bhrqak,brakhd->brqhd', p_nb, vg)
           + jnp.einsum('bhrqc,bchd->brqhd', p_cx.astype(v.dtype), vc))
    return out.reshape(b, s, h * hd)


def project_heads(proj, rope, win_q_norm, win_k_norm, dif_q_norm, dif_k_norm, nat_q_norm, nat_k_norm,
                  mla_q_a_norm, mla_wq_b, mla_kv_a_norm, mla_wkv_b, mla_q_norm, mla_k_norm):
    split_at = np.cumsum(IN_SIZES)[:-1].tolist()
    (wq, wk, wv, dq, dk, dv, nq, nk, nv, mqa, mkva, gates) = jnp.split(proj, split_at, axis=-1)
    b, t = proj.shape[:2]
    wq = rms_norm(wq.reshape(b, t, WIN_HEADS, HEAD_DIM), win_q_norm)
    wk = rms_norm(wk.reshape(b, t, WIN_KV_HEADS, HEAD_DIM), win_k_norm)
    wv = wv.reshape(b, t, WIN_KV_HEADS, HEAD_DIM)
    dq = rms_norm(dq.reshape(b, t, 2 * DIF_HEADS, DIF_QK_DIM), dif_q_norm)
    dk = rms_norm(dk.reshape(b, t, 2 * DIF_HEADS, DIF_QK_DIM), dif_k_norm)
    dv = dv.reshape(b, t, DIF_HEADS, DIF_V_DIM)
    nq = rms_norm(nq.reshape(b, t, NAT_HEADS, HEAD_DIM), nat_q_norm)
    nk = rms_norm(nk.reshape(b, t, NAT_HEADS, HEAD_DIM), nat_k_norm)
    nv = nv.reshape(b, t, NAT_HEADS, HEAD_DIM)
    mq = (rms_norm(mqa, mla_q_a_norm) @ mla_wq_b).reshape(b, t, MLA_HEADS, MLA_NOPE + MLA_ROPE)
    ckv, k_rope = mkva[..., :MLA_KV_LORA], mkva[..., MLA_KV_LORA:]
    kv = (rms_norm(ckv, mla_kv_a_norm) @ mla_wkv_b).reshape(b, t, MLA_HEADS, MLA_NOPE + MLA_V)
    mk = jnp.concatenate([kv[..., :MLA_NOPE],
                          jnp.broadcast_to(k_rope[:, :, None, :], (b, t, MLA_HEADS, MLA_ROPE))], axis=-1)
    mv = kv[..., MLA_NOPE:]
    mq = rms_norm(mq, mla_q_norm)
    mk = rms_norm(mk, mla_k_norm)
    if rope is not None:
        cos_h, sin_h, cos_m, sin_m = rope
        wq = apply_rope(wq, cos_h, sin_h)
        wk = apply_rope(wk, cos_h, sin_h)
        dq = apply_rope(dq, cos_h, sin_h)
        dk = apply_rope(dk, cos_h, sin_h)
        mq = jnp.concatenate([mq[..., :MLA_NOPE], apply_rope(mq[..., MLA_NOPE:], cos_m, sin_m)], axis=-1)
        mk = jnp.concatenate([mk[..., :MLA_NOPE], apply_rope(mk[..., MLA_NOPE:], cos_m, sin_m)], axis=-1)
    dq = dq.reshape(b, t, DIF_HEADS, 2, DIF_QK_DIM)
    dk = dk.reshape(b, t, DIF_HEADS, 2, DIF_QK_DIM)
    return (wq, wk, wv, dq, dk, dv, nq, nk, nv, mq, mk, mv, gates)


def merge_branches(ys, gates, w_branch, w_out):
    b, t = gates.shape[:2]
    yb = jnp.einsum('btnw,nwd->btnd', jnp.stack(ys, axis=2), w_branch)
    g = jax.nn.sigmoid(gates.reshape(b, t, N_BRANCH, D_MODEL))
    return (g * yb).sum(axis=2) @ w_out


def moe(tok, router_w, router_b, w1, w3, w2):
    n, d = tok.shape
    per_group = N_EXPERTS // N_GROUPS
    scores = jax.nn.sigmoid((tok @ router_w).astype(jnp.float32))
    biased = scores + router_b.astype(jnp.float32)
    group_score = lax.top_k(biased.reshape(n, N_GROUPS, per_group), 2)[0].sum(-1)
    group = jnp.argmax(group_score, axis=-1)
    in_group = (jnp.arange(N_EXPERTS) // per_group)[None, :] == group[:, None]
    _, idx = lax.top_k(jnp.where(in_group, biased, -jnp.inf), TOP_K)
    wts = jnp.take_along_axis(scores, idx, axis=-1)
    wts = wts / wts.sum(-1, keepdims=True)
    flat_e = idx.reshape(-1).astype(jnp.int32)
    flat_w = wts.reshape(-1)
    flat_t = jnp.repeat(jnp.arange(n, dtype=jnp.int32), TOP_K)
    order = jnp.argsort(flat_e)
    se, st, sw = flat_e[order], flat_t[order], flat_w[order]
    counts = jnp.bincount(flat_e, length=N_EXPERTS)
    padded = (counts + MOE_BLOCK - 1) // MOE_BLOCK * MOE_BLOCK
    start = jnp.cumsum(counts) - counts
    pad_end = jnp.cumsum(padded)
    pad_start = pad_end - padded
    dest = pad_start[se] + jnp.arange(n * TOP_K) - start[se]
    n_blk = (n * TOP_K + N_EXPERTS * (MOE_BLOCK - 1) + MOE_BLOCK - 1) // MOE_BLOCK
    cap = n_blk * MOE_BLOCK
    buf_t = jnp.full((cap,), n, jnp.int32).at[dest].set(st)
    buf_w = jnp.zeros((cap,), tok.dtype).at[dest].set(sw.astype(tok.dtype))
    blk_e = jnp.minimum(jnp.searchsorted(pad_end, jnp.arange(n_blk) * MOE_BLOCK, side='right'), N_EXPERTS - 1)
    xs = jnp.concatenate([tok, jnp.zeros((1, d), tok.dtype)], axis=0)[buf_t].reshape(n_blk, MOE_BLOCK, d)

    def expert_block(args):
        xb, e = args
        return (jax.nn.silu(xb @ w1[e]) * (xb @ w3[e])) @ w2[e]

    ys = lax.map(expert_block, (xs, blk_e)).reshape(cap, d) * buf_w[:, None]
    return jnp.zeros((n + 1, d), tok.dtype).at[buf_t].add(ys)[:n]


def trunk_layer(x, xc, c, c_ctx, rope, lam_init, want_ctx,
                ada_w, ada_b, norm1_g, norm2_g, w_in,
                win_q_norm, win_k_norm, win_sink,
                dif_q_norm, dif_k_norm, dif_lambda, dif_subln,
                nat_q_norm, nat_k_norm, nat_rpb,
                mla_q_a_norm, mla_wq_b, mla_kv_a_norm, mla_wkv_b, mla_q_norm, mla_k_norm,
                w_branch, w_out, router_w, router_b, moe_w1, moe_w3, moe_w2):
    b, s, d = x.shape
    mod = jax.nn.silu(c) @ ada_w + ada_b
    mod_c = jax.nn.silu(c_ctx) @ ada_w + ada_b
    sh1, sc1, g1, sh2, sc2, g2 = [m[:, None, :] for m in jnp.split(mod, 6, axis=-1)]
    sh1c, sc1c, g1c, sh2c, sc2c, g2c = jnp.split(mod_c, 6, axis=-1)

    h = rms_norm(x, norm1_g) * (1.0 + sc1) + sh1
    hc = rms_norm(xc, norm1_g) * (1.0 + sc1c) + sh1c
    head_params = (win_q_norm, win_k_norm, dif_q_norm, dif_k_norm, nat_q_norm, nat_k_norm,
                   mla_q_a_norm, mla_wq_b, mla_kv_a_norm, mla_wkv_b, mla_q_norm, mla_k_norm)
    (wq, wk, wv, dq, dk, dv, nq, nk, nv, mq, mk, mv, gates) = project_heads(h @ w_in, rope, *head_params)
    (wqc, wkc, wvc, dqc, dkc, dvc, nqc, nkc, nvc, mqc, mkc, mvc, gates_c) = project_heads(hc @ w_in, None, *head_params)

    lam_f = dif_lambda.astype(jnp.float32)
    lam = jnp.exp(jnp.sum(lam_f[0] * lam_f[1])) - jnp.exp(jnp.sum(lam_f[2] * lam_f[3])) + lam_init

    def dif_out(y):
        return flat_heads(rms_norm(y, dif_subln) * (1.0 - lam_init))

    ys = [
        window_attention(wq, wk, wv, wkc, wvc, win_sink),
        dif_out(diff_attention(dq, jnp.concatenate([dkc, dk], axis=1), jnp.concatenate([dvc, dv], axis=1), lam)),
        neighbourhood_attention(nq, nk, nv, nkc, nvc, nat_rpb),
        flat_heads(dense_attention(mq, jnp.concatenate([mkc, mk], axis=1), jnp.concatenate([mvc, mv], axis=1))),
    ]
    x = x + g1 * merge_branches(ys, gates, w_branch, w_out)
    h2 = rms_norm(x, norm2_g) * (1.0 + sc2) + sh2
    tokens = h2.reshape(b * s, d)
    if want_ctx:
        ysc = [
            window_attention_context(wqc, wkc, wvc, win_sink),
            dif_out(diff_attention(dqc, dkc, dvc, lam)),
            flat_heads(dense_attention(nqc, nkc, nvc)),
            flat_heads(dense_attention(mqc, mkc, mvc)),
        ]
        xc = xc + g1c * merge_branches(ysc, gates_c, w_branch, w_out)
        h2c = rms_norm(xc, norm2_g) * (1.0 + sc2c) + sh2c
        tokens = jnp.concatenate([tokens, h2c.reshape(-1, d)], axis=0)
    f = moe(tokens, router_w, router_b, moe_w1, moe_w3, moe_w2)
    x = x + g2 * f[: b * s].reshape(b, s, d)
    if want_ctx:
        xc = xc + g2c * f[b * s:].reshape(xc.shape)
    return x, xc


def _normal(k, shape, std):
    return jax.random.normal(k, shape, jnp.float32) * std


def setup_inputs(seed: int = 0) -> dict:
    key = jax.random.key(seed)
    k = jax.random.split(key, 32)
    L, D = DEPTH, D_MODEL
    return {
        'x': _normal(k[0], (BATCH, SEQ, D), 1.0),
        'c': _normal(k[1], (BATCH, D), 1.0),
        'ctx': _normal(k[2], (BATCH, CTX_LEN, D), 1.0),
        'c_ctx': _normal(k[3], (D,), 1.0),
        'ada_w': _normal(k[4], (L, D, 6 * D), 0.5 * D ** -0.5),
        'ada_b': _normal(k[5], (L, 6 * D), 0.02),
        'norm1_g': 1.0 + _normal(k[6], (L, D), 0.05),
        'norm2_g': 1.0 + _normal(k[7], (L, D), 0.05),
        'w_in': _normal(k[8], (L, D, D_IN), D ** -0.5),
        'win_q_norm': 1.0 + _normal(k[9], (L, HEAD_DIM), 0.05),
        'win_k_norm': 1.0 + _normal(k[10], (L, HEAD_DIM), 0.05),
        'win_sink': _normal(k[11], (L, WIN_HEADS), 0.5),
        'dif_q_norm': 1.0 + _normal(k[12], (L, DIF_QK_DIM), 0.05),
        'dif_k_norm': 1.0 + _normal(k[13], (L, DIF_QK_DIM), 0.05),
        'dif_lambda': _normal(k[14], (L, 4, DIF_QK_DIM), 0.1),
        'dif_subln': 1.0 + _normal(k[15], (L, DIF_V_DIM), 0.05),
        'nat_q_norm': 1.0 + _normal(k[16], (L, HEAD_DIM), 0.05),
        'nat_k_norm': 1.0 + _normal(k[17], (L, HEAD_DIM), 0.05),
        'nat_rpb': _normal(k[18], (L, NAT_HEADS, 2 * NAT_WIN_ROWS - 1, 2 * NAT_WIN_COLS - 1), 0.1),
        'mla_q_a_norm': 1.0 + _normal(k[19], (L, MLA_Q_LORA), 0.05),
        'mla_wq_b': _normal(k[20], (L, MLA_Q_LORA, MLA_HEADS * (MLA_NOPE + MLA_ROPE)), MLA_Q_LORA ** -0.5),
        'mla_kv_a_norm': 1.0 + _normal(k[21], (L, MLA_KV_LORA), 0.05),
        'mla_wkv_b': _normal(k[22], (L, MLA_KV_LORA, MLA_HEADS * (MLA_NOPE + MLA_V)), MLA_KV_LORA ** -0.5),
        'mla_q_norm': 1.0 + _normal(k[23], (L, MLA_NOPE + MLA_ROPE), 0.05),
        'mla_k_norm': 1.0 + _normal(k[24], (L, MLA_NOPE + MLA_ROPE), 0.05),
        'w_branch': _normal(k[25], (L, N_BRANCH, BRANCH_W, D), BRANCH_W ** -0.5),
        'w_out': _normal(k[26], (L, D, D), D ** -0.5),
        'router_w': _normal(k[27], (D, N_EXPERTS), D ** -0.5),
        'router_b': _normal(k[28], (N_EXPERTS,), 0.01),
        'moe_w1': _normal(k[29], (L, N_EXPERTS, D, D_EXPERT), D ** -0.5),
        'moe_w3': _normal(k[30], (L, N_EXPERTS, D, D_EXPERT), D ** -0.5),
        'moe_w2': _normal(k[31], (L, N_EXPERTS, D_EXPERT, D), D_EXPERT ** -0.5),
    }


def reference(x, c, ctx, c_ctx, ada_w, ada_b, norm1_g, norm2_g, w_in,
              win_q_norm, win_k_norm, win_sink,
              dif_q_norm, dif_k_norm, dif_lambda, dif_subln,
              nat_q_norm, nat_k_norm, nat_rpb,
              mla_q_a_norm, mla_wq_b, mla_kv_a_norm, mla_wkv_b, mla_q_norm, mla_k_norm,
              w_branch, w_out, router_w, router_b, moe_w1, moe_w3, moe_w2):
    s = x.shape[1]
    rope = rope_cos_sin(s, HEAD_DIM, x.dtype) + rope_cos_sin(s, MLA_ROPE, x.dtype)
    xc = ctx
    for l in range(DEPTH):
        lam_init = 0.8 - 0.6 * math.exp(-0.3 * l)
        x, xc = trunk_layer(
            x, xc, c, c_ctx, rope, lam_init, l < DEPTH - 1,
            ada_w[l], ada_b[l], norm1_g[l], norm2_g[l], w_in[l],
            win_q_norm[l], win_k_norm[l], win_sink[l],
            dif_q_norm[l], dif_k_norm[l], dif_lambda[l], dif_subln[l],
            nat_q_norm[l], nat_k_norm[l], nat_rpb[l],
            mla_q_a_norm[l], mla_wq_b[l], mla_kv_a_norm[l], mla_wkv_b[l], mla_q_norm[l], mla_k_norm[l],
            w_branch[l], w_out[l], router_w, router_b, moe_w1[l], moe_w3[l], moe_w2[l])
    return x
```

```cpp
#include <hip/hip_runtime.h>
#include <hip/hip_cooperative_groups.h>
#include <stdint.h>
#include <stdio.h>
namespace cg = cooperative_groups;

#ifndef ONE_LAUNCH
#define ONE_LAUNCH 1
#endif
#ifndef STOP_STAGE
#define STOP_STAGE 20
#endif
#ifndef DUMP_OFF
#define DUMP_OFF OFF_MK
#define DUMP_LD 768
#endif
#ifndef REP_LO
#define REP_LO 0
#define REP_HI -1
#endif
#ifndef REP7
#define REP7 0
#endif
#ifndef OPC
#define OPC 0
#endif
#ifndef REP_KIND
#define REP_KIND 0
#endif
#ifndef DQB
#define DQB 2
#endif
#ifndef PH_ONLY
#define PH_ONLY 0
#endif
#ifndef BRANCH_MASK
#define BRANCH_MASK 15
#endif

typedef unsigned short u16;
using bf16x8 = __attribute__((ext_vector_type(8))) short;
using bf16x4 = __attribute__((ext_vector_type(4))) short;
using f32x4  = __attribute__((ext_vector_type(4))) float;
using f32x16 = __attribute__((ext_vector_type(16))) float;
using u32x4  = __attribute__((ext_vector_type(4))) unsigned;
#define DEVI __device__ __forceinline__

constexpr int D = 1024, SEQ = 8192, NB = 2, CTXL = 256;
constexpr int NLAT = NB * SEQ;
constexpr int NROW = NLAT + NB * CTXL;
constexpr int DIN = 8352;
constexpr int NASSIGN = 2 * NROW;
constexpr int LCAP = NROW;
constexpr float EPS = 1e-6f;
constexpr float LOG2E = 1.4426950408889634f;

enum { I_X = 0, I_C, I_CTX, I_CCTX, I_ADAW, I_ADAB, I_N1G, I_N2G, I_WIN, I_WINQN, I_WINKN, I_SINK, I_DIFQN, I_DIFKN, I_DIFLAM, I_SUBLN,
       I_NATQN, I_NATKN, I_RPB, I_MQAN, I_WQB, I_MKVAN, I_WKVB, I_MQN, I_MKN, I_WBR, I_WOUT, I_RW, I_RB, I_W1, I_W3, I_W2 };

constexpr size_t SZ512 = (size_t)NROW * 512 * 2, SZ768 = (size_t)NROW * 768 * 2, SZ128 = (size_t)NROW * 128 * 2;
constexpr size_t OFF_WQ = 0;
constexpr size_t OFF_DQ = OFF_WQ + SZ512;
constexpr size_t OFF_NQ = OFF_DQ + SZ512;
constexpr size_t OFF_YD = OFF_NQ + SZ512;
constexpr size_t OFF_MQ = OFF_YD + SZ512;
constexpr size_t OFF_QEND = OFF_MQ + SZ768;
constexpr size_t OFF_WK = OFF_QEND;
constexpr size_t OFF_WV = OFF_WK + SZ128;
constexpr size_t OFF_DK = OFF_WV + SZ128;
constexpr size_t OFF_DV = OFF_DK + SZ512;
constexpr size_t OFF_NK = OFF_DV + SZ512;
constexpr size_t OFF_NV = OFF_NK + SZ512;
constexpr size_t OFF_MK = OFF_NV + SZ512;
constexpr size_t OFF_MV = OFF_MK + SZ768;
constexpr size_t OFF_KVEND = OFF_MV + SZ512;
constexpr int TMPLD = 416;
constexpr size_t OFF_TMP = OFF_KVEND;
constexpr size_t OFF_H = OFF_TMP + (size_t)NROW * TMPLD * 2;
constexpr size_t OFF_WT = OFF_H + (size_t)NROW * 1024 * 2;
constexpr size_t WT_WIN = 0;
constexpr size_t WT_WB = WT_WIN + (size_t)8448 * 1024 * 2;
constexpr size_t WT_WO = WT_WB + (size_t)4 * 1024 * 512 * 2;
constexpr size_t WT_WQB = WT_WO + (size_t)1024 * 1024 * 2;
constexpr size_t WT_WKVB = WT_WQB + (size_t)768 * 256 * 2;
constexpr size_t WT_LAYER = WT_WKVB + (size_t)1024 * 128 * 2;
constexpr size_t OFF_SMALL = OFF_WT + 2 * WT_LAYER;
constexpr size_t OFF_MODS = OFF_SMALL;
constexpr size_t OFF_TAB64 = OFF_MODS + (size_t)2 * 3 * 6144 * 4;
constexpr size_t OFF_TAB32 = OFF_TAB64 + 128 * 16 * 8;
constexpr size_t OFF_CONST = OFF_TAB32 + 128 * 8 * 8;
constexpr size_t OFF_CNT = OFF_CONST + 2 * 32 * 4;
constexpr size_t OFF_LIST = OFF_CNT + 256;
constexpr size_t OFF_TOKW = OFF_LIST + (size_t)16 * LCAP * 4;
constexpr size_t OFF_XC = OFF_TOKW + (size_t)NASSIGN * 4;
constexpr size_t OFF_BAR = OFF_XC + (size_t)512 * 1024 * 4;
constexpr size_t OFF_RWT = OFF_BAR + 16384;
constexpr size_t OFF_YS2 = OFF_RWT + 65536;
constexpr DEVI size_t ys_off(int n) { return n < 2 ? OFF_H + (size_t)n * SZ512 : OFF_YS2 + (size_t)(n - 2) * SZ512; }
constexpr int G1_SPLIT = 5888;
constexpr size_t OFF_GB = OFF_YS2 + 2 * SZ512;
constexpr size_t WS_END = OFF_GB + (size_t)(NLAT - G1_SPLIT) * 4096;
constexpr size_t OFF_YBUF = OFF_WQ;
constexpr size_t OFF_M = OFF_WK;
constexpr size_t OFF_MOEW13 = OFF_M + (size_t)NROW * 1024 * 2;
constexpr size_t OFF_MOEW2 = OFF_MOEW13 + (size_t)16 * 1024 * 1024 * 2;
constexpr size_t OFF_HEXP = OFF_MOEW2 + (size_t)16 * 1024 * 512 * 2;
static_assert(OFF_HEXP + (size_t)(NASSIGN + 256) * 512 * 2 <= OFF_KVEND, "KV-area aliases overflow");
static_assert(OFF_YBUF + (size_t)NASSIGN * 1024 * 2 <= OFF_QEND, "Q-area alias overflow");

constexpr int AQB = 1;
constexpr int NW = 8, NTHR = 64 * NW;
constexpr int BM = 256;
constexpr int LDS_BYTES = 147456 + 256;
constexpr int LDS_TIDTAB = LDS_BYTES - 16 - 256;

struct Params { const float* in[32]; float* out; char* ws; };
typedef const __attribute__((address_space(4))) Params& CPR;
typedef const __attribute__((address_space(4))) Params* KPTR;

#define LAS __attribute__((address_space(3)))
DEVI unsigned hw_slot() { return (unsigned)__builtin_amdgcn_s_getreg((5 << 11) | 4) & 63u; }
DEVI void tid_init() { if ((threadIdx.x & 63) == 0) *(volatile LAS int*)(LDS_TIDTAB + hw_slot() * 4) = (int)(threadIdx.x >> 6); __syncthreads(); }
DEVI int lane_opaque() { int t; asm volatile("v_mbcnt_lo_u32_b32 %0, -1, 0\n\tv_mbcnt_hi_u32_b32 %0, -1, %0" : "=&v"(t)); return t; }
DEVI float shx(float v, int m) { return __int_as_float(__builtin_amdgcn_ds_bpermute((lane_opaque() ^ m) << 2, __float_as_int(v))); }
DEVI float shl_(float v, int src) { return __int_as_float(__builtin_amdgcn_ds_bpermute(src << 2, __float_as_int(v))); }
DEVI float rflf(float x) { return __int_as_float(__builtin_amdgcn_readfirstlane(__float_as_int(x))); }
DEVI int TID() {
  const int w = __builtin_amdgcn_readfirstlane(*(volatile LAS int*)(LDS_TIDTAB + hw_slot() * 4));
  return w * 64 + lane_opaque();
}
DEVI float bf2f(u16 v) { return __uint_as_float(((unsigned)v) << 16); }
DEVI float lo_f(unsigned w) { return __uint_as_float(w << 16); }
DEVI float hi_f(unsigned w) { return __uint_as_float(w & 0xffff0000u); }
typedef __bf16 bf16v2_t __attribute__((ext_vector_type(2)));
typedef float f32v2_t __attribute__((ext_vector_type(2)));
DEVI unsigned pk2(float lo, float hi) { f32v2_t v = {lo, hi}; bf16v2_t b = __builtin_convertvector(v, bf16v2_t); return __builtin_bit_cast(unsigned, b); }
DEVI void st4(u16* p, float a, float b, float c, float d) { uint2 v; v.x = pk2(a, b); v.y = pk2(c, d); *(uint2*)p = v; }
DEVI float fexp2(float x) { return __builtin_amdgcn_exp2f(x); }
DEVI float sigmoidf_(float x) { return __builtin_amdgcn_rcpf(1.f + __builtin_amdgcn_exp2f(-x * LOG2E)); }
DEVI float wave_sum(float v) {
#pragma unroll
  for (int o = 1; o < 64; o <<= 1) v += shx(v, o);
  return v;
}

DEVI void glds16(const void* gsrc, char* lds_wave_base) { __builtin_amdgcn_global_load_lds((const unsigned*)gsrc, (unsigned*)lds_wave_base, 16, 0, 0); }
template <int BN, int WMW, int WNW, int NST = 2, class ARowF>
DEVI void gemm_tile(f32x4 (&acc)[BN / WNW / 16][BM / WMW / 16], ARowF arow, const u16* __restrict__ Wt, int ldw, int K, char* lds, int tid) {
  static_assert(WMW * WNW == NW, "eight waves");
  static_assert(NST == 2 || (BN % 64 == 0 && 3 * (BM * 128 + BN * 128) <= 131072), "ring: uniform loads per lane, slots below 128 KiB");
  constexpr int MI = BM / WMW / 16, NI = BN / WNW / 16, WMT = BM / WMW, WNT = BN / WNW, XB = BM * 128, BUFB = XB + BN * 128;
  constexpr int WPASS = (BN + 63) / 64;
  const int lane = tid & 63, wave = __builtin_amdgcn_readfirstlane(tid >> 6), wm = wave / WNW, wn = wave % WNW;
  const int srow = wave * 8 + (lane >> 3);
  const int schunk = (lane & 7) ^ ((srow >> 1) & 7);
  const u16* xp[BM / 64];
#pragma unroll
  for (int p = 0; p < BM / 64; ++p) xp[p] = arow(srow + 64 * p) + schunk * 8;
  const u16* wp = Wt + (size_t)srow * ldw + schunk * 8;
  auto issue = [&](int k0, int b) {
    char* Xs = lds + b * BUFB + wave * 1024; char* Ws = Xs + XB;
#pragma unroll
    for (int p = 0; p < BM / 64; ++p) glds16(xp[p] + k0, Xs + p * 8192);
#pragma unroll
    for (int p = 0; p < WPASS; ++p) if (p * 64 + wave * 8 < BN) glds16(wp + (size_t)(64 * p) * ldw + k0, Ws + p * 8192);
  };
  const int fsw = (lane >> 1) & 7, fq = lane >> 4;
  const int foff0 = (lane & 15) * 128 + ((fq ^ fsw) << 4), foff1 = (lane & 15) * 128 + (((4 + fq) ^ fsw) << 4);
  issue(0, 0);
  if (NST == 3) { if (K > 64) issue(64, 1); }
  else { asm volatile("s_waitcnt vmcnt(0)" ::: "memory"); __syncthreads(); }
  int b = 0;
  for (int k0 = 0; k0 < K; k0 += 64) {
    if (NST == 3) {
      if (k0 + 64 < K) asm volatile("s_waitcnt vmcnt(%0)" :: "n"(BM / 64 + WPASS) : "memory"); else asm volatile("s_waitcnt vmcnt(0)" ::: "memory");
      __syncthreads();
      if (k0 + 128 < K) issue(k0 + 128, b >= 1 ? b - 1 : 2);
    } else if (k0 + 64 < K) issue(k0 + 64, b ^ 1);
    const char* Xs = lds + b * BUFB; const char* Ws = Xs + XB;
#pragma unroll 1
    for (int kk = 0; kk < 2; ++kk) {
      const int fo = kk ? foff1 : foff0;
      bf16x8 wf[NI], xf[MI];
#pragma unroll
      for (int ni = 0; ni < NI; ++ni) wf[ni] = *(const bf16x8*)(Ws + (wn * WNT + ni * 16) * 128 + fo);
#pragma unroll
      for (int mi = 0; mi < MI; ++mi) xf[mi] = *(const bf16x8*)(Xs + (wm * WMT + mi * 16) * 128 + fo);
#pragma unroll
      for (int ni = 0; ni < NI; ++ni)
#pragma unroll
        for (int mi = 0; mi < MI; ++mi) acc[ni][mi] = __builtin_amdgcn_mfma_f32_16x16x32_bf16(wf[ni], xf[mi], acc[ni][mi], 0, 0, 0);
    }
    if (NST == 3) { b = b == 2 ? 0 : b + 1; }
    else { asm volatile("s_waitcnt vmcnt(0)" ::: "memory"); __syncthreads(); b ^= 1; }
  }
  if (NST == 3) __syncthreads();
}

DEVI int g8_lds_byte(int r, int c) { const int st = (r >> 4) * 2 + (c >> 5), rr = r & 15, cc = c & 31, ob = rr * 64 + cc * 2; return st * 1024 + (ob ^ (((ob >> 9) & 1) << 5)); }
DEVI void g8_stage_rc(int b, int& R, int& C) { const int st = b >> 10, sb = b & 1023, swz = sb ^ (((sb >> 9) & 1) << 5); R = (st >> 1) * 16 + (swz >> 6); C = (st & 1) * 32 + ((swz & 63) >> 1); }
template <bool GATHER, int MODE, class XOffF>
DEVI void gemm256(f32x4 (&acc)[2][2][4][2], const u16* __restrict__ W, int ldw, const u16* __restrict__ X, XOffF xrowoff, int K, char* lds, int tid) {
  constexpr int HT = 128 * 64 * 2;
  const int wid = __builtin_amdgcn_readfirstlane(tid >> 6), lane = tid & 63, wr = wid >> 2, wc = wid & 3, fr = lane & 15, fq = lane >> 4;
  unsigned woff[2], xoff[2], xoff1[GATHER ? 2 : 1];
#pragma unroll
  for (int i = 0; i < 2; ++i) { int r_, c_; g8_stage_rc(tid * 16 + i * 8192, r_, c_); woff[i] = (unsigned)(r_ * ldw + c_) * 2u; xoff[i] = (unsigned)(xrowoff(r_) + c_) * 2u; if (GATHER) xoff1[i] = (unsigned)(xrowoff(128 + r_) + c_) * 2u; }
  const char* W1 = (const char*)(W + (size_t)128 * ldw); const char* X1 = (const char*)(GATHER ? X : X + (size_t)xrowoff(128));
  const char* W0 = (const char*)W; const char* X0 = (const char*)X;
#define G8_STAGE_X1(P, kt) do { const char* _b = X1 + (size_t)((kt) * 128); asm volatile("" : "+s"(_b)); _Pragma("unroll") for (int _i = 0; _i < 2; ++_i) glds16(_b + (size_t)(GATHER ? xoff1[GATHER ? _i : 0] : xoff[_i]), (P) + wid * 1024 + _i * 8192); } while (0)
#define G8_SA(b, h) (lds + ((b) * 2 + (h)) * HT)
#define G8_SB(b, h) (lds + (4 + (b) * 2 + (h)) * HT)
#define G8_STAGE(P, base, off, kt) do { const char* _b = (base) + (size_t)((kt) * 128); asm volatile("" : "+s"(_b)); _Pragma("unroll") for (int _i = 0; _i < 2; ++_i) glds16(_b + (size_t)off[_i], (P) + wid * 1024 + _i * 8192); } while (0)
#define G8_LDA(dst, b, h) do { _Pragma("unroll") for (int m = 0; m < 4; ++m) _Pragma("unroll") for (int k = 0; k < 2; ++k) dst[m][k] = *(const bf16x8*)(G8_SA(b, h) + ldsA + (m * 2048 + k * 1024)); } while (0)
#define G8_LDB(dst, b, h) do { _Pragma("unroll") for (int n = 0; n < 2; ++n) _Pragma("unroll") for (int k = 0; k < 2; ++k) dst[n][k] = *(const bf16x8*)(G8_SB(b, h) + ldsB + (n * 2048 + k * 1024)); } while (0)
#define G8_MMA(ai, bj, At, Bt) do { __builtin_amdgcn_s_setprio(1); _Pragma("unroll") for (int m = 0; m < 4; ++m) _Pragma("unroll") for (int n = 0; n < 2; ++n) _Pragma("unroll") for (int k = 0; k < 2; ++k) \
    acc[ai][bj][m][n] = __builtin_amdgcn_mfma_f32_16x16x32_bf16(At[m][k], Bt[n][k], acc[ai][bj][m][n], 0, 0, 0); __builtin_amdgcn_s_setprio(0); } while (0)
#define G8_WV(n) asm volatile("s_waitcnt vmcnt(" #n ")" ::: "memory")
#define G8_WL(n) asm volatile("s_waitcnt lgkmcnt(" #n ")" ::: "memory")
#define G8_BAR __builtin_amdgcn_s_barrier()
#define G8_SCHED __builtin_amdgcn_sched_barrier(0)
  bf16x8 At[4][2], B0[2][2], B1[2][2];
  int ldsA = g8_lds_byte(wr * 64 + fr, fq * 8), ldsB = g8_lds_byte(wc * 32 + fr, fq * 8);
  asm volatile("" : "+v"(ldsA), "+v"(ldsB));
  const int nt = K >> 6;
  if (MODE != 2) {
    G8_STAGE(G8_SB(0, 0), X0, xoff, 0); G8_STAGE(G8_SA(0, 0), W0, woff, 0);
    G8_STAGE_X1(G8_SB(0, 1), 0); G8_STAGE(G8_SA(0, 1), W1, woff, 0);
    G8_STAGE(G8_SB(1, 0), X0, xoff, 1); G8_STAGE(G8_SA(1, 0), W0, woff, 1); G8_STAGE_X1(G8_SB(1, 1), 1);
  }
  if (MODE == 1) return;
  if (wr == 1) G8_BAR;
  if (MODE == 2) { G8_WV(0); G8_BAR; G8_BAR; }
  else { G8_WV(10); G8_BAR; G8_WV(6); G8_BAR; }
#pragma unroll 1
  for (int t = 0; t < nt - 2; t += 2) {
    G8_LDB(B0, 0, 0); G8_SCHED; G8_LDA(At, 0, 0); G8_STAGE(G8_SA(1, 1), W1, woff, t + 1);
    G8_WL(8); G8_BAR; G8_WL(0); G8_MMA(0, 0, At, B0); G8_BAR; G8_SCHED;
    G8_LDB(B1, 0, 1); G8_STAGE(G8_SB(0, 0), X0, xoff, t + 2);
    G8_BAR; G8_WL(0); G8_MMA(0, 1, At, B1); G8_BAR;
    G8_LDA(At, 0, 1); G8_STAGE(G8_SA(0, 0), W0, woff, t + 2);
    G8_BAR; G8_WL(0); G8_MMA(1, 0, At, B0); G8_BAR; G8_SCHED;
    G8_STAGE_X1(G8_SB(0, 1), t + 2);
    G8_WV(6); G8_BAR; G8_MMA(1, 1, At, B1); G8_BAR;
    G8_LDB(B0, 1, 0); G8_SCHED; G8_LDA(At, 1, 0); G8_STAGE(G8_SA(0, 1), W1, woff, t + 2);
    G8_WL(8); G8_BAR; G8_WL(0); G8_MMA(0, 0, At, B0); G8_BAR; G8_SCHED;
    G8_LDB(B1, 1, 1); G8_STAGE(G8_SB(1, 0), X0, xoff, t + 3);
    G8_BAR; G8_WL(0); G8_MMA(0, 1, At, B1); G8_BAR;
    G8_LDA(At, 1, 1); G8_STAGE(G8_SA(1, 0), W0, woff, t + 3);
    G8_BAR; G8_WL(0); G8_MMA(1, 0, At, B0); G8_BAR; G8_SCHED;
    G8_STAGE_X1(G8_SB(1, 1), t + 3);
    G8_WV(6); G8_BAR; G8_MMA(1, 1, At, B1); G8_BAR;
  }
  { G8_LDB(B0, 0, 0); G8_LDA(At, 0, 0); G8_STAGE(G8_SA(1, 1), W1, woff, nt - 1);
    G8_BAR; G8_WL(0); G8_MMA(0, 0, At, B0); G8_BAR;
    G8_LDB(B1, 0, 1); G8_BAR; G8_WL(0); G8_MMA(0, 1, At, B1); G8_BAR;
    G8_LDA(At, 0, 1); G8_WV(4); G8_BAR; G8_WL(0); G8_MMA(1, 0, At, B0); G8_MMA(1, 1, At, B1); G8_BAR; }
  { G8_LDB(B0, 1, 0); G8_LDA(At, 1, 0); G8_WV(2); G8_BAR; G8_WL(0); G8_MMA(0, 0, At, B0); G8_BAR;
    G8_LDB(B1, 1, 1); G8_WV(0); G8_BAR; G8_WL(0); G8_MMA(0, 1, At, B1); G8_BAR;
    G8_LDA(At, 1, 1); G8_BAR; G8_WL(0); G8_MMA(1, 0, At, B0); G8_MMA(1, 1, At, B1); G8_BAR; }
  if (wr == 0) G8_BAR;
  __syncthreads();
}

struct ConvD { const float* src; const float* ksc; u16* dst; int K, N, mode; };
DEVI int conv_dstrow(int mode, int n) {
  if (mode == 1) return n < 4256 ? n : n + 96;
  if (mode == 2) return (n >> 5) * 64 + (n & 31);
  if (mode == 3) return (n >> 5) * 64 + 32 + (n & 31);
  return n;
}
DEVI void tr_item64(const float* __restrict__ src, int N, int K, int k0, int n0, const float* __restrict__ ksc, u16* __restrict__ dst, int mode, float* scr, int lane) {
  const int c = lane & 15, rr = lane >> 4;
  const bool colok = n0 + 4 * c < N;
  float4 v[16];
#pragma unroll
  for (int i = 0; i < 16; ++i) { const int k = 4 * i + rr; v[i] = colok ? *(const float4*)(src + (size_t)(k0 + k) * N + n0 + 4 * c) : make_float4(0.f, 0.f, 0.f, 0.f); }
#pragma unroll
  for (int i = 0; i < 16; ++i) { const int k = 4 * i + rr; float4 x = v[i];
    if (ksc) { const float f = ksc[k0 + k]; x.x *= f; x.y *= f; x.z *= f; x.w *= f; }
    *(float4*)(scr + k * 68 + 4 * c) = x; }
  asm volatile("s_waitcnt lgkmcnt(0)" ::: "memory");
  const int n = n0 + lane;
  if (n < N) {
    u16* drow = dst + (size_t)conv_dstrow(mode, n) * K + k0;
#pragma unroll
    for (int cc = 0; cc < 8; ++cc) { const float* sp = scr + (8 * cc) * 68 + lane;
      uint4 o; o.x = pk2(sp[0], sp[68]); o.y = pk2(sp[136], sp[204]); o.z = pk2(sp[272], sp[340]); o.w = pk2(sp[408], sp[476]);
      *(uint4*)(drow + 8 * cc) = o; }
  }
  asm volatile("s_waitcnt lgkmcnt(0)" ::: "memory");
}
DEVI int conv_nitems(int K, int N) { return (K >> 6) * ((N + 63) >> 6); }
DEVI ConvD p0_desc(CPR p, int d) {
  const int l = d >> 3, j = d & 7; ConvD c; c.ksc = nullptr; c.mode = 0;
  char* wt = p.ws + OFF_WT + (size_t)l * WT_LAYER;
  if (j == 0) { c.src = p.in[I_WIN] + (size_t)l * 1024 * DIN; c.K = 1024; c.N = DIN; c.dst = (u16*)(wt + WT_WIN); c.mode = 1; }
  else if (j <= 4) { int n = j - 1; c.src = p.in[I_WBR] + (size_t)(l * 4 + n) * 512 * 1024; c.K = 512; c.N = 1024; c.dst = (u16*)(wt + WT_WB) + (size_t)n * 1024 * 512; }
  else if (j == 5) { c.src = p.in[I_WOUT] + (size_t)l * 1024 * 1024; c.K = 1024; c.N = 1024; c.dst = (u16*)(wt + WT_WO); }
  else if (j == 6) { c.src = p.in[I_WQB] + (size_t)l * 256 * 768; c.K = 256; c.N = 768; c.dst = (u16*)(wt + WT_WQB); c.ksc = p.in[I_MQAN] + l * 256; }
  else { c.src = p.in[I_WKVB] + (size_t)l * 128 * 1024; c.K = 128; c.N = 1024; c.dst = (u16*)(wt + WT_WKVB); c.ksc = p.in[I_MKVAN] + l * 128; }
  return c;
}
DEVI ConvD moe_desc(CPR p, int l, int d) {
  const int e = d / 3, w = d % 3; ConvD c; c.ksc = nullptr;
  if (w < 2) { c.src = p.in[w == 0 ? I_W1 : I_W3] + (size_t)(l * 16 + e) * 1024 * 512; c.K = 1024; c.N = 512; c.dst = (u16*)(p.ws + OFF_MOEW13) + (size_t)e * 1024 * 1024; c.mode = 2 + w; }
  else { c.src = p.in[I_W2] + (size_t)(l * 16 + e) * 512 * 1024; c.K = 512; c.N = 1024; c.dst = (u16*)(p.ws + OFF_MOEW2) + (size_t)e * 1024 * 512; c.mode = 0; }
  return c;
}
template <class DescF>
DEVI void conv_run_w(int ndesc, int total, DescF descf, char* scr_base, int wave0, int nwv) {
  const int tid = TID(), lane = tid & 63, wave = tid >> 6;
  if (wave < wave0 || wave >= wave0 + nwv) return;
  float* scr = (float*)scr_base + (wave - wave0) * (64 * 68);
  for (int item = blockIdx.x * nwv + (wave - wave0); item < total; item += gridDim.x * nwv) {
    ConvD c; c.src = nullptr; c.ksc = nullptr; c.dst = nullptr; c.K = 64; c.N = 64; c.mode = 0;
    int rem = item;
    for (int d = 0; d < ndesc; ++d) {
      ConvD t = descf(d); const int n = conv_nitems(t.K, t.N);
      if (rem < n) { c = t; break; }
      rem -= n;
    }
    const int nbn = (c.N + 63) >> 6; const int k0 = (rem / nbn) * 64, n0 = (rem % nbn) * 64;
    tr_item64(c.src, c.N, c.K, k0, n0, c.ksc, c.dst, c.mode, scr, lane);
  }
}
template <class DescF>
DEVI void conv_run(int ndesc, int total, DescF descf, char* lds) { conv_run_w(ndesc, total, descf, lds, 0, NW); __syncthreads(); }

DEVI void phase0(CPR p, char* lds) {
  const int tid = TID();
  {
    int total = 0;
    for (int d = 0; d < 16; ++d) { ConvD t = p0_desc(p, d); total += conv_nitems(t.K, t.N); }
    conv_run(16, total, [&](int d) { return p0_desc(p, d); }, lds);
  }
  {
    float* s = (float*)lds; float* red = s + 3072;
    float* mods = (float*)(p.ws + OFF_MODS);
    for (int it = blockIdx.x; it < 384; it += gridDim.x) {
      const int l = it / 192, j0 = (it % 192) * 32;
      for (int i = tid; i < 3072; i += NTHR) { int r = i >> 10, k = i & 1023; float cv = r < 2 ? p.in[I_C][r * 1024 + k] : p.in[I_CCTX][k]; s[i] = cv / (1.f + __expf(-cv)); }
      __syncthreads();
      const int j = tid & 31, kq = tid >> 5;
      const float* W = p.in[I_ADAW] + (size_t)l * 1024 * 6144 + j0 + j;
      float a0 = 0, a1 = 0, a2 = 0;
#pragma unroll 16
      for (int k = kq * 64; k < kq * 64 + 64; ++k) { float w = W[(size_t)k * 6144]; a0 += s[k] * w; a1 += s[1024 + k] * w; a2 += s[2048 + k] * w; }
      red[(kq * 3 + 0) * 32 + j] = a0; red[(kq * 3 + 1) * 32 + j] = a1; red[(kq * 3 + 2) * 32 + j] = a2;
      __syncthreads();
      if (tid < 96) { int r = tid >> 5, jj = tid & 31; float v = p.in[I_ADAB][l * 6144 + j0 + jj];
        for (int q = 0; q < 16; ++q) v += red[(q * 3 + r) * 32 + jj];
        mods[(size_t)(l * 3 + r) * 6144 + j0 + jj] = v; }
      __syncthreads();
    }
  }
  {
    float2* t64 = (float2*)(p.ws + OFF_TAB64); float2* t32 = (float2*)(p.ws + OFF_TAB32);
    const int gb = (int)gridDim.x - 1 - (int)blockIdx.x;
    if (gb >= 1 && gb <= 4) { const int i = (gb - 1) * NTHR + tid; const int pos = i >> 4, j = i & 15; float f = expf(-logf(10000.f) * (float)j / 16.f); float ang = (float)pos * f; t64[i] = make_float2((float)cos((double)ang), (float)sin((double)ang)); }
    if (gb >= 5 && gb <= 6) { const int i = (gb - 5) * NTHR + tid; const int pos = i >> 3, j = i & 7; float f = expf(-logf(10000.f) * (float)j / 8.f); float ang = (float)pos * f; t32[i] = make_float2((float)cos((double)ang), (float)sin((double)ang)); }
    if (gb >= 7 && gb < 7 + 32) { const int i = (gb - 7) * NTHR + tid; const int e = i >> 10, k = i & 1023; ((float*)(p.ws + OFF_RWT))[i] = p.in[I_RW][k * 16 + e]; }
  }
  if (blockIdx.x == gridDim.x - 1) {
    if (tid < 32) ((int*)(p.ws + OFF_CNT))[tid] = 0;
    const int lane = tid & 63, wave = tid >> 6;
    auto wmax = [&](float v) {
#pragma unroll
      for (int o = 1; o < 64; o <<= 1) v = fmaxf(v, shx(v, o));
      return v; };
    auto amax = [&](const float* a, int n) { float m = 0.f; for (int i = lane; i < n; i += 64) m = fmaxf(m, fabsf(a[i])); return wmax(m); };
    if (wave < 2) {
      const int l = wave; float* cst = (float*)(p.ws + OFF_CONST) + l * 32;
      const float* lm = p.in[I_DIFLAM] + l * 256;
      const float s01 = wave_sum(lm[lane] * lm[64 + lane]), s23 = wave_sum(lm[128 + lane] * lm[192 + lane]);
      const float lam_init = 0.8f - 0.6f * expf(-0.3f * (float)l);
      const float c2 = 8.f * amax(p.in[I_WINQN] + l * 64, 64) * amax(p.in[I_WINKN] + l * 64, 64);
      const float c3 = 8.f * amax(p.in[I_DIFQN] + l * 64, 64) * amax(p.in[I_DIFKN] + l * 64, 64);
      const float c4 = 8.f * amax(p.in[I_NATQN] + l * 64, 64) * amax(p.in[I_NATKN] + l * 64, 64);
      const float c5 = sqrtf(96.f) * amax(p.in[I_MQN] + l * 96, 96) * amax(p.in[I_MKN] + l * 96, 96);
      if (lane == 0) { cst[0] = expf(s01) - expf(s23) + lam_init; cst[1] = lam_init; cst[2] = c2; cst[3] = c3; cst[4] = c4; cst[5] = c5; }
    }
    for (int q = wave; q < 16; q += NW) {
      const int l = q >> 3, h = q & 7; const float m = amax(p.in[I_RPB] + (size_t)(l * 8 + h) * 465, 465);
      if (lane == 0) ((float*)(p.ws + OFF_CONST))[l * 32 + 8 + h] = m;
    }
  }
}

DEVI void moe_combine(CPR p, int row, int lane, float4 (&v)[4], const float* g2) {
  const u16* yb = (const u16*)(p.ws + OFF_YBUF); const float* tw = (const float*)(p.ws + OFF_TOKW);
  const float w0 = tw[row * 2], w1 = tw[row * 2 + 1];
#pragma unroll
  for (int j = 0; j < 4; ++j) {
    const int k = lane * 4 + 256 * j;
    uint2 a = *(const uint2*)(yb + (size_t)(row * 2) * 1024 + k), b = *(const uint2*)(yb + (size_t)(row * 2 + 1) * 1024 + k);
    float4 g = *(const float4*)(g2 + k);
    v[j].x += g.x * (w0 * lo_f(a.x) + w1 * lo_f(b.x)); v[j].y += g.y * (w0 * hi_f(a.x) + w1 * hi_f(b.x));
    v[j].z += g.z * (w0 * lo_f(a.y) + w1 * lo_f(b.y)); v[j].w += g.w * (w0 * hi_f(a.y) + w1 * hi_f(b.y));
  }
}
DEVI void phase1(CPR p, int l, char* lds) {
  const int tid = TID(), lane = tid & 63, wave = tid >> 6;
  const float* mods = (const float*)(p.ws + OFF_MODS);
  u16* H = (u16*)(p.ws + OFF_H);
  for (int row = blockIdx.x * NW + wave; row < NROW; row += gridDim.x * NW) {
    const bool lat = row < NLAT; const int ridx = lat ? (row >> 13) : 2;
    const float* src;
    if (l == 0) src = lat ? p.in[I_X] + (size_t)row * 1024 : p.in[I_CTX] + (size_t)(row - NLAT) * 1024;
    else src = lat ? p.out + (size_t)row * 1024 : (const float*)(p.ws + OFF_XC) + (size_t)(row - NLAT) * 1024;
    float4 v[4];
#pragma unroll
    for (int j = 0; j < 4; ++j) v[j] = *(const float4*)(src + lane * 4 + 256 * j);
    if (l == 1) {
      moe_combine(p, row, lane, v, mods + (size_t)(0 * 3 + ridx) * 6144 + 5120);
      if (lat) {
#pragma unroll
        for (int j = 0; j < 4; ++j) *(float4*)(p.out + (size_t)row * 1024 + lane * 4 + 256 * j) = v[j];
      }
    }
    float ss = 0;
#pragma unroll
    for (int j = 0; j < 4; ++j) ss += v[j].x * v[j].x + v[j].y * v[j].y + v[j].z * v[j].z + v[j].w * v[j].w;
    ss = wave_sum(ss);
    const float rs = rsqrtf(ss * (1.f / 1024.f) + EPS);
    const float* md = mods + (size_t)(l * 3 + ridx) * 6144; const float* ng = p.in[I_N1G] + l * 1024;
#pragma unroll
    for (int j = 0; j < 4; ++j) {
      const int k = lane * 4 + 256 * j;
      float4 g = *(const float4*)(ng + k), sh = *(const float4*)(md + k), sc = *(const float4*)(md + 1024 + k);
      st4(H + (size_t)row * 1024 + k, v[j].x * rs * g.x * (1.f + sc.x) + sh.x, v[j].y * rs * g.y * (1.f + sc.y) + sh.y,
          v[j].z * rs * g.z * (1.f + sc.z) + sh.z, v[j].w * rs * g.w * (1.f + sc.w) + sh.w);
    }
  }
}
DEVI void phase_final(CPR p) {
  const int tid = TID(), lane = tid & 63, wave = tid >> 6;
  const float* mods = (const float*)(p.ws + OFF_MODS);
  for (int row = blockIdx.x * NW + wave; row < NLAT; row += gridDim.x * NW) {
    float4 v[4];
#pragma unroll
    for (int j = 0; j < 4; ++j) v[j] = *(const float4*)(p.out + (size_t)row * 1024 + lane * 4 + 256 * j);
    moe_combine(p, row, lane, v, mods + (size_t)(1 * 3 + (row >> 13)) * 6144 + 5120);
#pragma unroll
    for (int j = 0; j < 4; ++j) *(float4*)(p.out + (size_t)row * 1024 + lane * 4 + 256 * j) = v[j];
  }
}

DEVI bool xcd_tile(int idx, int nM, int nN, int& mt, int& nt) {
  const int x = idx & 7, y = idx >> 3;
  const int Mx = (nM - x + 7) >> 3;
  if (y >= Mx * nN) return false;
  const int mg = y / (8 * nN);
  const int mh = (Mx - 8 * mg) < 8 ? (Mx - 8 * mg) : 8;
  int rem = y - mg * 8 * nN;
  const int ng = rem / (mh * 8);
  rem -= ng * mh * 8;
  mt = x + 8 * (8 * mg + rem % mh); nt = ng * 8 + rem / mh;
  return true;
}
DEVI int xcd_slots(int nM, int nN) { return 8 * ((nM + 7) >> 3) * nN; }

static_assert((size_t)G1_SPLIT * 4096 <= WT_LAYER && NROW - NLAT <= NLAT - G1_SPLIT, "gate buffers");
DEVI unsigned char* gate_row(CPR p, int l, int row) {
  if (l == 0) return row < NLAT ? (unsigned char*)p.out + (size_t)row * 4096 : (unsigned char*)(p.ws + OFF_GB) + (size_t)(row - NLAT) * 4096;
  return row < G1_SPLIT ? (unsigned char*)(p.ws + OFF_WT) + (size_t)row * 4096 : (unsigned char*)(p.ws + OFF_GB) + (size_t)(row - G1_SPLIT) * 4096;
}
DEVI void p2_item(CPR p, int l, int mt, int nt2, bool hasNext, int mtN, int ntN, char* lds) {
  const int tid = TID(), lane = tid & 63, wave = __builtin_amdgcn_readfirstlane(tid >> 6), wr = wave >> 2, wc = wave & 3;
  const u16* H = (const u16*)(p.ws + OFF_H) + (size_t)mt * BM * 1024;
  const u16* Wt = (const u16*)(p.ws + OFF_WT + (size_t)l * WT_LAYER + WT_WIN) + (size_t)nt2 * 256 * 1024;
  f32x4 acc[2][2][4][2];
#pragma unroll
  for (int a = 0; a < 2; ++a)
#pragma unroll
    for (int b = 0; b < 2; ++b)
#pragma unroll
      for (int c = 0; c < 4; ++c) { acc[a][b][c][0] = f32x4{0, 0, 0, 0}; acc[a][b][c][1] = f32x4{0, 0, 0, 0}; }
  gemm256<false, 2>(acc, Wt, 1024, H, [&](int r) { return r * 1024; }, 1024, lds, tid);
  if (hasNext) gemm256<false, 1>(acc, (const u16*)(p.ws + OFF_WT + (size_t)l * WT_LAYER + WT_WIN) + (size_t)ntN * 256 * 1024, 1024, (const u16*)(p.ws + OFF_H) + (size_t)mtN * BM * 1024, [&](int r) { return r * 1024; }, 1024, lds, tid);
  const bool lat = mt < NLAT / BM; const int c4 = (lane >> 4) * 4;
  if (nt2 >= 17) {
#pragma unroll
    for (int bj = 0; bj < 2; ++bj)
#pragma unroll
      for (int n = 0; n < 2; ++n) {
        unsigned char* grow = gate_row(p, l, mt * BM + bj * 128 + wc * 32 + n * 16 + (lane & 15)) + (nt2 - 17) * 256 + wr * 64 + c4;
#pragma unroll
        for (int ai = 0; ai < 2; ++ai)
#pragma unroll
          for (int m = 0; m < 4; ++m) { const f32x4 v = acc[ai][bj][m][n];
            const unsigned q0 = (unsigned)(sigmoidf_(v[0]) * 255.f + 0.5f), q1 = (unsigned)(sigmoidf_(v[1]) * 255.f + 0.5f), q2 = (unsigned)(sigmoidf_(v[2]) * 255.f + 0.5f), q3 = (unsigned)(sigmoidf_(v[3]) * 255.f + 0.5f);
            *(unsigned*)(grow + ai * 128 + m * 16) = q0 | (q1 << 8) | (q2 << 16) | (q3 << 24); }
      }
    return;
  }
  const float2* t64 = (const float2*)(p.ws + OFF_TAB64);
#pragma unroll
  for (int ai = 0; ai < 2; ++ai) {
    const int nt = nt2 * 2 + ai;
    size_t doff; int ldd, dcol; const float* nw = nullptr; bool rope = false; int ncols = 128;
    if (nt < 4)       { doff = OFF_WQ; ldd = 512; dcol = nt * 128; nw = p.in[I_WINQN] + l * 64; rope = true; }
    else if (nt == 4) { doff = OFF_WK; ldd = 128; dcol = 0; nw = p.in[I_WINKN] + l * 64; rope = true; }
    else if (nt == 5) { doff = OFF_WV; ldd = 128; dcol = 0; }
    else if (nt < 10) { doff = OFF_DQ; ldd = 512; dcol = (nt - 6) * 128; nw = p.in[I_DIFQN] + l * 64; rope = true; }
    else if (nt < 14) { doff = OFF_DK; ldd = 512; dcol = (nt - 10) * 128; nw = p.in[I_DIFKN] + l * 64; rope = true; }
    else if (nt < 18) { doff = OFF_DV; ldd = 512; dcol = (nt - 14) * 128; }
    else if (nt < 22) { doff = OFF_NQ; ldd = 512; dcol = (nt - 18) * 128; nw = p.in[I_NATQN] + l * 64; }
    else if (nt < 26) { doff = OFF_NK; ldd = 512; dcol = (nt - 22) * 128; nw = p.in[I_NATKN] + l * 64; }
    else if (nt < 30) { doff = OFF_NV; ldd = 512; dcol = (nt - 26) * 128; }
    else if (nt < 32) { doff = OFF_TMP; ldd = TMPLD; dcol = (nt - 30) * 128; }
    else if (nt == 32) { doff = OFF_TMP; ldd = TMPLD; dcol = 256; }
    else { doff = OFF_TMP; ldd = TMPLD; dcol = 384; ncols = 32; }
    u16* dst = (u16*)(p.ws + doff);
    const float qs = (nt < 4 || (nt >= 6 && nt < 10) || (nt >= 18 && nt < 22)) ? 0.125f * LOG2E : 1.f;
#pragma unroll
    for (int bj = 0; bj < 2; ++bj)
#pragma unroll
      for (int n = 0; n < 2; ++n) {
        const int row = mt * BM + bj * 128 + wc * 32 + n * 16 + (lane & 15);
        float v[4][4];
#pragma unroll
        for (int ni = 0; ni < 4; ++ni)
#pragma unroll
          for (int r = 0; r < 4; ++r) v[ni][r] = acc[ai][bj][ni][n][r];
        if (nw) {
          float ss = 0;
#pragma unroll
          for (int ni = 0; ni < 4; ++ni)
#pragma unroll
            for (int r = 0; r < 4; ++r) ss += v[ni][r] * v[ni][r];
          ss += shx(ss, 16); ss += shx(ss, 32);
          const float rs = rsqrtf(ss * (1.f / 64.f) + EPS) * qs;
#pragma unroll
          for (int ni = 0; ni < 4; ++ni) { float4 g = *(const float4*)(nw + ni * 16 + c4);
            v[ni][0] *= rs * g.x; v[ni][1] *= rs * g.y; v[ni][2] *= rs * g.z; v[ni][3] *= rs * g.w; }
          if (rope && lat) {
            const int t = row & 8191, pr = t >> 6, pc = t & 63;
#pragma unroll
            for (int r = 0; r < 4; ++r) {
              float2 a = t64[pr * 16 + c4 + r]; float x1 = v[0][r], x2 = v[2][r]; v[0][r] = x1 * a.x - x2 * a.y; v[2][r] = x1 * a.y + x2 * a.x;
              float2 b = t64[pc * 16 + c4 + r]; x1 = v[1][r]; x2 = v[3][r]; v[1][r] = x1 * b.x - x2 * b.y; v[3][r] = x1 * b.y + x2 * b.x;
            }
          }
        }
#pragma unroll
        for (int ni = 0; ni < 4; ++ni) { const int col = wr * 64 + ni * 16 + c4;
          if (col < ncols) st4(dst + (size_t)row * ldd + dcol + col, v[ni][0], v[ni][1], v[ni][2], v[ni][3]); }
      }
  }
}

DEVI int p2_next(int l, int it, int& mt, int& nt) {
  constexpr int NMAIN = (NLAT / BM) * 33;
  if (it < NMAIN) { xcd_tile(it, NLAT / BM, 33, mt, nt); return it; }
  const int j = it - NMAIN, nseg = (l == 0) ? 33 : 17;
  if (j >= 2 * nseg) return -1;
  mt = NLAT / BM + (j & 1); nt = j >> 1;
  return it;
}
DEVI void phase2(CPR p, int l, char* lds) {
  int mt = 0, nt = 0, it = p2_next(l, blockIdx.x, mt, nt);
  if (it < 0) return;
  { f32x4 dummy[2][2][4][2]; const int tid = TID();
    gemm256<false, 1>(dummy, (const u16*)(p.ws + OFF_WT + (size_t)l * WT_LAYER + WT_WIN) + (size_t)nt * 256 * 1024, 1024, (const u16*)(p.ws + OFF_H) + (size_t)mt * BM * 1024, [&](int r) { return r * 1024; }, 1024, lds, tid); }
  while (it >= 0) {
    int mtN = 0, ntN = 0; const int itN = p2_next(l, it + gridDim.x, mtN, ntN);
    p2_item(p, l, mt, nt, itN >= 0, mtN, ntN, lds);
    it = itN; mt = mtN; nt = ntN;
  }
}

template <int KD>
DEVI void p3_rowscale(const u16* tmp_rows  , float* rsA, int tid) {
  const int row = tid >> 1, half = tid & 1; const u16* s = tmp_rows + (size_t)row * TMPLD + half * (KD / 2);
  float ss = 0;
#pragma unroll
  for (int i = 0; i < KD / 16; ++i) { uint4 u = *(const uint4*)(s + i * 8);
    ss += lo_f(u.x) * lo_f(u.x) + hi_f(u.x) * hi_f(u.x) + lo_f(u.y) * lo_f(u.y) + hi_f(u.y) * hi_f(u.y) + lo_f(u.z) * lo_f(u.z) + hi_f(u.z) * hi_f(u.z) + lo_f(u.w) * lo_f(u.w) + hi_f(u.w) * hi_f(u.w); }
  ss += shx(ss, 1);
  if (half == 0) rsA[row] = rsqrtf(ss * (1.f / (float)KD) + EPS);
}
DEVI void p3_item(CPR p, int l, int item, char* lds) {
  const int tid = TID(), lane = tid & 63, wave = tid >> 6;
  const int mt = item >> 4, hh = (item ^ ((item >> 8) << 3)) & 15;
  const u16* TMP = (const u16*)(p.ws + OFF_TMP);
  float* rsA = (float*)(lds + 98304);
  const bool lat = mt < NLAT / BM; const int q = lane >> 4, c4 = q * 4;
  const float2* t32 = (const float2*)(p.ws + OFF_TAB32);
  if (hh < 8) {
    const int h = hh;
    p3_rowscale<256>(TMP + (size_t)mt * BM * TMPLD, rsA, tid);
    f32x4 acc[6][2];
#pragma unroll
    for (int a = 0; a < 6; ++a) { acc[a][0] = f32x4{0, 0, 0, 0}; acc[a][1] = f32x4{0, 0, 0, 0}; }
    const u16* Wt = (const u16*)(p.ws + OFF_WT + (size_t)l * WT_LAYER + WT_WQB) + (size_t)h * 96 * 256;
    gemm_tile<96, 8, 1>(acc, [&](int r) { return TMP + (size_t)(mt * BM + r) * TMPLD; }, Wt, 256, 256, lds, tid);
    const float* gq = p.in[I_MQN] + l * 96; u16* MQ = (u16*)(p.ws + OFF_MQ);
#pragma unroll
    for (int mi = 0; mi < 2; ++mi) {
      const int rl = wave * 32 + mi * 16 + (lane & 15), row = mt * BM + rl; const float ra = rsA[rl];
      float v[6][4]; float ss = 0;
#pragma unroll
      for (int ni = 0; ni < 6; ++ni)
#pragma unroll
        for (int r = 0; r < 4; ++r) { v[ni][r] = acc[ni][mi][r] * ra; ss += v[ni][r] * v[ni][r]; }
      ss += shx(ss, 16); ss += shx(ss, 32);
      const float rs = rsqrtf(ss * (1.f / 96.f) + EPS) * (0.10206207261596575f * LOG2E);
#pragma unroll
      for (int ni = 0; ni < 6; ++ni) { float4 g = *(const float4*)(gq + ni * 16 + c4);
        v[ni][0] *= rs * g.x; v[ni][1] *= rs * g.y; v[ni][2] *= rs * g.z; v[ni][3] *= rs * g.w; }
      if (lat) {
        const int t = row & 8191; const int pos = (q < 2) ? (t >> 6) : (t & 63);
#pragma unroll
        for (int r = 0; r < 4; ++r) { float2 a = t32[pos * 8 + (q & 1) * 4 + r]; float x1 = v[4][r], x2 = v[5][r]; v[4][r] = x1 * a.x - x2 * a.y; v[5][r] = x1 * a.y + x2 * a.x; }
      }
#pragma unroll
      for (int ni = 0; ni < 6; ++ni) st4(MQ + (size_t)row * 768 + h * 96 + ni * 16 + c4, v[ni][0], v[ni][1], v[ni][2], v[ni][3]);
    }
  } else {
    const int h = hh - 8;
    p3_rowscale<128>(TMP + (size_t)mt * BM * TMPLD + 256, rsA, tid);
    f32x4 acc[8][2];
#pragma unroll
    for (int a = 0; a < 8; ++a) { acc[a][0] = f32x4{0, 0, 0, 0}; acc[a][1] = f32x4{0, 0, 0, 0}; }
    const u16* Wt = (const u16*)(p.ws + OFF_WT + (size_t)l * WT_LAYER + WT_WKVB) + (size_t)h * 128 * 128;
    gemm_tile<128, 8, 1>(acc, [&](int r) { return TMP + (size_t)(mt * BM + r) * TMPLD + 256; }, Wt, 128, 128, lds, tid);
    const float* gk = p.in[I_MKN] + l * 96; u16* MK = (u16*)(p.ws + OFF_MK); u16* MV = (u16*)(p.ws + OFF_MV);
#pragma unroll
    for (int mi = 0; mi < 2; ++mi) {
      const int rl = wave * 32 + mi * 16 + (lane & 15), row = mt * BM + rl; const float ra = rsA[rl];
      float kn[4][4], kr0[4], kr1[4]; float ss = 0;
#pragma unroll
      for (int ni = 0; ni < 4; ++ni)
#pragma unroll
        for (int r = 0; r < 4; ++r) { kn[ni][r] = acc[ni][mi][r] * ra; ss += kn[ni][r] * kn[ni][r]; }
      { uint2 a = *(const uint2*)(TMP + (size_t)row * TMPLD + 384 + c4), b = *(const uint2*)(TMP + (size_t)row * TMPLD + 400 + c4);
        kr0[0] = lo_f(a.x); kr0[1] = hi_f(a.x); kr0[2] = lo_f(a.y); kr0[3] = hi_f(a.y);
        kr1[0] = lo_f(b.x); kr1[1] = hi_f(b.x); kr1[2] = lo_f(b.y); kr1[3] = hi_f(b.y); }
#pragma unroll
      for (int r = 0; r < 4; ++r) ss += kr0[r] * kr0[r] + kr1[r] * kr1[r];
      ss += shx(ss, 16); ss += shx(ss, 32);
      const float rs = rsqrtf(ss * (1.f / 96.f) + EPS);
#pragma unroll
      for (int ni = 0; ni < 4; ++ni) { float4 g = *(const float4*)(gk + ni * 16 + c4);
        kn[ni][0] *= rs * g.x; kn[ni][1] *= rs * g.y; kn[ni][2] *= rs * g.z; kn[ni][3] *= rs * g.w; }
      { float4 g0 = *(const float4*)(gk + 64 + c4), g1 = *(const float4*)(gk + 80 + c4);
        kr0[0] *= rs * g0.x; kr0[1] *= rs * g0.y; kr0[2] *= rs * g0.z; kr0[3] *= rs * g0.w;
        kr1[0] *= rs * g1.x; kr1[1] *= rs * g1.y; kr1[2] *= rs * g1.z; kr1[3] *= rs * g1.w; }
      if (lat) {
        const int t = row & 8191; const int pos = (q < 2) ? (t >> 6) : (t & 63);
#pragma unroll
        for (int r = 0; r < 4; ++r) { float2 a = t32[pos * 8 + (q & 1) * 4 + r]; float x1 = kr0[r], x2 = kr1[r]; kr0[r] = x1 * a.x - x2 * a.y; kr1[r] = x1 * a.y + x2 * a.x; }
      }
      u16* mk = MK + (size_t)row * 768 + h * 96;
#pragma unroll
      for (int ni = 0; ni < 4; ++ni) st4(mk + ni * 16 + c4, kn[ni][0], kn[ni][1], kn[ni][2], kn[ni][3]);
      st4(mk + 64 + c4, kr0[0], kr0[1], kr0[2], kr0[3]); st4(mk + 80 + c4, kr1[0], kr1[1], kr1[2], kr1[3]);
#pragma unroll
      for (int ni = 4; ni < 8; ++ni) st4(MV + (size_t)row * 512 + h * 64 + (ni - 4) * 16 + c4, acc[ni][mi][0] * ra, acc[ni][mi][1] * ra, acc[ni][mi][2] * ra, acc[ni][mi][3] * ra);
    }
  }
}

constexpr int VBLK = 64 * 64;
typedef short s16x4_t __attribute__((ext_vector_type(4)));
DEVI bf16x4 tr_read(const char* p) { return __builtin_amdgcn_ds_read_tr16_b64_v4i16((__attribute__((address_space(3))) s16x4_t*)(p)); }
template <int DK, int KL, int DV, int QB, class PF>
DEVI void attn_tile_compute(const char* Ks, const char* Vs, const bf16x8 (&qf)[QB][DK / 16], f32x16 (&o)[QB][DV / 32], float (&lsum)[QB], PF pf, int lane, int isel) {
  const int r32 = lane & 31, hi = lane >> 5;
  const char* vlane = Vs + (((lane & 15) >> 2) + 4 * hi) * 64 + (16 * ((lane >> 4) & 1) + 4 * (lane & 3)) * 2;
  auto qk = [&](int kb, f32x16 (&s)[QB]) {
#pragma unroll
    for (int qb = 0; qb < QB; ++qb)
#pragma unroll
      for (int r = 0; r < 16; ++r) s[qb][r] = 0.f;
#pragma unroll
    for (int ks = 0; ks < DK / 16; ++ks) {
      const char* ap;
      if (KL == 1) ap = Ks + (kb * 32 + r32) * 256 + (((isel * 8 + ks * 2 + hi) ^ (r32 & 15)) << 4);
      else if (KL == 2 && ks >= 4) ap = Ks + 8192 + (kb * 32 + r32) * 64 + ((((ks - 4) * 2 + hi) ^ ((r32 >> 2) & 3)) << 4);
      else ap = Ks + (kb * 32 + r32) * 128 + (((ks * 2 + hi) ^ ((r32 >> 1) & 7)) << 4);
      bf16x8 a = *(const bf16x8*)ap;
#pragma unroll
      for (int qb = 0; qb < QB; ++qb) s[qb] = __builtin_amdgcn_mfma_f32_32x32x16_bf16(a, qf[qb][ks], s[qb], 0, 0, 0);
    }
  };
  auto softmax = [&](const f32x16& s, int kb, int qb, bf16x8 (&pb)[2]) {
    float pv[16];
#pragma unroll
    for (int r = 0; r < 16; ++r) { const int key = kb * 32 + (r & 3) + 8 * (r >> 2) + 4 * hi; pv[r] = pf(qb, s[r], key); lsum[qb] += pv[r]; }
#pragma unroll
    for (int s2 = 0; s2 < 2; ++s2) {
      u32x4 w = {pk2(pv[8 * s2 + 0], pv[8 * s2 + 1]), pk2(pv[8 * s2 + 2], pv[8 * s2 + 3]), pk2(pv[8 * s2 + 4], pv[8 * s2 + 5]), pk2(pv[8 * s2 + 6], pv[8 * s2 + 7])};
      pb[s2] = __builtin_bit_cast(bf16x8, w);
    }
  };
  auto ldv = [&](int kb, int i) {
    const char* vp = vlane + (i % (DV / 32)) * VBLK + (kb * 32 + (i / (DV / 32)) * 16) * 64;
    const bf16x4 v0 = tr_read(vp), v1 = tr_read(vp + 8 * 64);
    const bf16x8 va = {v0[0], v0[1], v0[2], v0[3], v1[0], v1[1], v1[2], v1[3]};
    return va;
  };
  auto pvmm = [&](int kb, const bf16x8 (&pb)[QB][2]) {
    constexpr int NF = 2 * (DV / 32);
    bf16x8 va = ldv(kb, 0);
#pragma unroll
    for (int i = 0; i < NF; ++i) {
      bf16x8 vn = va;
      if (i + 1 < NF) vn = ldv(kb, i + 1);
#pragma unroll
      for (int qb = 0; qb < QB; ++qb) o[qb][i % (DV / 32)] = __builtin_amdgcn_mfma_f32_32x32x16_bf16(va, pb[qb][i / (DV / 32)], o[qb][i % (DV / 32)], 0, 0, 0);
      va = vn;
    }
  };
  if (QB * DV >= 256) {
    bf16x8 p0[QB][2];
#pragma unroll
    for (int kb = 0; kb < 2; ++kb) {
      f32x16 s0[QB];
      qk(kb, s0);
#pragma unroll
      for (int qb = 0; qb < QB; ++qb) softmax(s0[qb], kb, qb, p0[qb]);
      pvmm(kb, p0);
    }
    return;
  }
  f32x16 s0[QB], s1[QB];
  qk(0, s0);
  qk(1, s1);
  bf16x8 p0[QB][2], p1[QB][2];
#pragma unroll
  for (int qb = 0; qb < QB; ++qb) softmax(s0[qb], 0, qb, p0[qb]);
  pvmm(0, p0);
#pragma unroll
  for (int qb = 0; qb < QB; ++qb) softmax(s1[qb], 1, qb, p1[qb]);
  pvmm(1, p1);
}

enum { AM_DENSE = 0, AM_WIN = 1, AM_NAT = 2 };
DEVI int nat_rstart(int r) { int s = r - 4; s = s < 0 ? 0 : s; return s > 120 ? 120 : s; }

template <int DK, int DKT, int DV, int MODE, bool DIF, int QB, bool SHIFT>
DEVI void attn_block(const u16* Qp, int ldq, const u16* __restrict__ Kp, int ldk, const u16* __restrict__ Vp, int ldv,
                     u16* Op, int ldo, int b, bool latq, int qpos0, float M2, float sinkterm,
                     const float* __restrict__ rpb, float lam, const float* __restrict__ subln, float oscale, char* lds) {
  constexpr int KL = (DKT == 64) ? 0 : (DKT == 128 ? 1 : 2);
  M2 = rflf(M2); sinkterm = rflf(sinkterm); lam = rflf(lam); oscale = rflf(oscale);
  constexpr int KBYTES = 64 * DKT * 2, VBYTES = (DV / 32) * VBLK, BUFB = KBYTES + VBYTES, NPW = (BUFB + 8191) / 8192;
  constexpr int NQ = (DIF ? 128 : 256) * QB;
  const int tid = TID(), lane = tid & 63, wave = __builtin_amdgcn_readfirstlane(tid >> 6), r32 = lane & 31, hi = lane >> 5;
  float* rpbs = (float*)(lds + 2 * BUFB);
  const int qbase = DIF ? ((wave & 3) * 32 * QB) : (wave * 32 * QB);
  const int isel = DIF ? (wave >> 2) : 0;
  bf16x8 qf[QB][DK / 16];
#pragma unroll
  for (int qb = 0; qb < QB; ++qb) {
    const u16* qrow = Qp + (size_t)(qbase + qb * 32 + r32) * ldq + isel * 64 + hi * 8;
#pragma unroll
    for (int ks = 0; ks < DK / 16; ++ks) qf[qb][ks] = *(const bf16x8*)(qrow + ks * 16);
  }
  int NT = 4, lo = 0;
  if (MODE == AM_DENSE) { NT = latq ? 4 + SEQ / 64 : 4; }
  else if (MODE == AM_WIN) { if (latq) { const int nb0 = qpos0 >> 7, nb1 = (qpos0 + NQ - 1) >> 7; lo = nb0 > 0 ? nb0 - 1 : 0; const int hb = nb1 < 63 ? nb1 + 1 : 63; NT = 4 + (hb - lo + 1) * 2; lo *= 128; } }
  else { const int r0 = qpos0 >> 6, r1 = (qpos0 + NQ - 1) >> 6; lo = nat_rstart(r0); NT = 4 + (nat_rstart(r1) + 7 - lo + 1); lo *= 64; }
  auto tile_row0 = [&](int t) { return t < 4 ? NLAT + b * CTXL + t * 64 : b * SEQ + lo + (t - 4) * 64; };
  if (MODE == AM_NAT) { for (int i = tid; i < 704; i += NTHR) { const int k = i - 128; rpbs[i] = (k >= 0 && k < 465) ? rpb[k] * LOG2E - (SHIFT ? M2 : 0.f) : 0.f; } }
  const int qpos = qpos0 + qbase + r32;
  const int qr = (qpos0 + qbase) >> 6, jq = qpos & 63;
  const int rsq = nat_rstart(qr);
  unsigned soff[NPW];
#pragma unroll
  for (int i = 0; i < NPW; ++i) {
    const int pc = i * NW + wave;
    if (pc * 1024 < KBYTES) {
      if (KL == 1) { const int row = pc * 4 + (lane >> 4), c = (lane & 15) ^ (row & 15); soff[i] = (unsigned)(row * ldk + c * 8) * 2u; }
      else if (KL == 2 && pc >= 8) { const int row = (pc - 8) * 16 + (lane >> 2), c = (lane & 3) ^ ((row >> 2) & 3); soff[i] = (unsigned)(row * ldk + 64 + c * 8) * 2u; }
      else { const int row = pc * 8 + (lane >> 3), c = (lane & 7) ^ ((row >> 1) & 7); soff[i] = (unsigned)(row * ldk + c * 8) * 2u; }
    } else {
      const int pv = pc - KBYTES / 1024, blk = pv >> 2, key = (pv & 3) * 16 + (lane >> 2);
      soff[i] = (unsigned)(key * ldv + blk * 32 + (lane & 3) * 8) * 2u;
    }
  }
  auto issue = [&](int t, int buf) {
    const int row0 = tile_row0(t);
    const u16* kb_ = Kp + (size_t)row0 * ldk; const u16* vb_ = Vp + (size_t)row0 * ldv;
    char* dst = lds + buf * BUFB + wave * 1024;
#pragma unroll
    for (int i = 0; i < NPW; ++i) { const int pc = i * NW + wave;
      if (KL == 1) {
        const char* sb_ = (const char*)(i < 2 ? kb_ + (size_t)(i * 32) * ldk : vb_ + (i - 2) * 64);
        asm volatile("" : "+s"(sb_));
        glds16(sb_ + (size_t)soff[i < 2 ? 0 : 2], dst + i * 8192);
      } else if (pc * 1024 < BUFB) { const char* sb_ = (const char*)(pc * 1024 < KBYTES ? kb_ : vb_); asm volatile("" : "+s"(sb_)); glds16(sb_ + (size_t)soff[i], dst + i * 8192); } }
  };
  f32x16 o[QB][DV / 32];
#pragma unroll
  for (int qb = 0; qb < QB; ++qb)
#pragma unroll
    for (int i = 0; i < DV / 32; ++i)
#pragma unroll
      for (int r = 0; r < 16; ++r) o[qb][i][r] = 0.f;
  float lsum[QB];
#pragma unroll
  for (int qb = 0; qb < QB; ++qb) lsum[qb] = 0.f;
  issue(0, 0);
  asm volatile("s_waitcnt vmcnt(0)" ::: "memory");
  __syncthreads();
  if (wave < 4) __builtin_amdgcn_s_setprio(2);
  for (int t = 0; t < NT; ++t) {
    const char* Ks = lds + (t & 1) * BUFB; const char* Vs = Ks + KBYTES;
    if (t + 1 < NT) issue(t + 1, (t + 1) & 1);
    if (MODE == AM_DENSE || t < 4) {
      attn_tile_compute<DK, KL, DV, QB>(Ks, Vs, qf, o, lsum, [&](int, float s, int) { return SHIFT ? fexp2(s - M2) : fexp2(s); }, lane, isel);
    } else if (MODE == AM_WIN) {
      const int kpt = lo + (t - 4) * 64, wq_lo = qpos0 + qbase;
      if (kpt + 63 >= wq_lo - 128 && kpt <= wq_lo + 32 * QB - 1 + 128) {
        const int kp0 = kpt - qpos;
        attn_tile_compute<DK, KL, DV, QB>(Ks, Vs, qf, o, lsum, [&](int qb, float s, int key) { const int d = kp0 + key - qb * 32; const float e = SHIFT ? fexp2(s - M2) : fexp2(s); return (d <= 128 && d >= -128) ? e : 0.f; }, lane, isel);
      }
    } else {
      const int kr = (lo >> 6) + (t - 4);
      if (kr >= rsq && kr < rsq + 8) {
        int cs[QB];
#pragma unroll
        for (int qb = 0; qb < QB; ++qb) { int c = jq + 32 * qb - 8; cs[qb] = c < 0 ? 0 : (c > 48 ? 48 : c); }
        const float* bl = rpbs + 128 + (kr - qr + 7) * 31 + 15 - jq;
        attn_tile_compute<DK, KL, DV, QB>(Ks, Vs, qf, o, lsum, [&](int qb, float s, int key) {
          const bool ok = (unsigned)(key - cs[qb]) < 16u;
          const float e = fexp2(s + bl[key - 32 * qb]); return ok ? e : 0.f; }, lane, isel);
      }
    }
    asm volatile("s_waitcnt vmcnt(0)" ::: "memory");
    __syncthreads();
  }
  __builtin_amdgcn_s_setprio(0);
  if (!DIF) {
#pragma unroll
    for (int qb = 0; qb < QB; ++qb) {
      const float ltot = lsum[qb] + shx(lsum[qb], 32) + sinkterm;
      const float inv = 1.f / ltot;
      u16* orow = Op + (size_t)(qbase + qb * 32 + r32) * ldo;
#pragma unroll
      for (int blk = 0; blk < DV / 32; ++blk)
#pragma unroll
        for (int g = 0; g < 4; ++g) st4(orow + blk * 32 + 8 * g + 4 * hi, o[qb][blk][4 * g] * inv, o[qb][blk][4 * g + 1] * inv, o[qb][blk][4 * g + 2] * inv, o[qb][blk][4 * g + 3] * inv);
    }
  } else {
    float* ex = (float*)lds;
    float inv[QB];
#pragma unroll
    for (int qb = 0; qb < QB; ++qb) inv[qb] = 1.f / (lsum[qb] + shx(lsum[qb], 32));
    if (isel == 1) {
#pragma unroll
      for (int qb = 0; qb < QB; ++qb) { const int qloc = qbase + qb * 32 + r32;
#pragma unroll
        for (int blk = 0; blk < DV / 32; ++blk)
#pragma unroll
          for (int g = 0; g < 4; ++g) *(float4*)(ex + qloc * 132 + blk * 32 + 8 * g + 4 * hi) = make_float4(o[qb][blk][4 * g] * inv[qb], o[qb][blk][4 * g + 1] * inv[qb], o[qb][blk][4 * g + 2] * inv[qb], o[qb][blk][4 * g + 3] * inv[qb]); }
    }
    __syncthreads();
    if (isel == 0) {
#pragma unroll
      for (int qb = 0; qb < QB; ++qb) { const int qloc = qbase + qb * 32 + r32;
        float ss = 0;
#pragma unroll
        for (int blk = 0; blk < DV / 32; ++blk)
#pragma unroll
          for (int g = 0; g < 4; ++g) { float4 o1 = *(const float4*)(ex + qloc * 132 + blk * 32 + 8 * g + 4 * hi);
            float a0 = o[qb][blk][4 * g] * inv[qb] - lam * o1.x, a1 = o[qb][blk][4 * g + 1] * inv[qb] - lam * o1.y, a2 = o[qb][blk][4 * g + 2] * inv[qb] - lam * o1.z, a3 = o[qb][blk][4 * g + 3] * inv[qb] - lam * o1.w;
            o[qb][blk][4 * g] = a0; o[qb][blk][4 * g + 1] = a1; o[qb][blk][4 * g + 2] = a2; o[qb][blk][4 * g + 3] = a3; ss += a0 * a0 + a1 * a1 + a2 * a2 + a3 * a3; }
        ss += shx(ss, 32);
        const float rs = rsqrtf(ss * (1.f / 128.f) + EPS) * oscale;
        u16* orow = Op + (size_t)qloc * ldo;
#pragma unroll
        for (int blk = 0; blk < DV / 32; ++blk)
#pragma unroll
          for (int g = 0; g < 4; ++g) { const int dv0 = blk * 32 + 8 * g + 4 * hi; float4 sl = *(const float4*)(subln + dv0);
            st4(orow + dv0, o[qb][blk][4 * g] * rs * sl.x, o[qb][blk][4 * g + 1] * rs * sl.y, o[qb][blk][4 * g + 2] * rs * sl.z, o[qb][blk][4 * g + 3] * rs * sl.w); }
      }
    }
    __syncthreads();
  }
}

template <int KIND>
DEVI void p4_item(CPR p, int l, int i, char* lds) {
  const float* cst = (const float*)(p.ws + OFF_CONST) + l * 32;
  constexpr bool latq = KIND < 4;
  int b, h, q0, qpos0;
  if (KIND == 0) { b = i / (256 / DQB); h = (i / (64 / DQB)) & 3; qpos0 = (i % (64 / DQB)) * 128 * DQB; }
  else if (KIND == 1) { b = i >> 7; h = (i >> 4) & 7; qpos0 = (i & 15) * 512; }
  else if (KIND < 4) { b = i >> 8; h = (i >> 5) & 7; qpos0 = (i & 31) * 256; }
  else if (KIND == 5) { b = i >> 3; h = (i >> 1) & 3; qpos0 = (i & 1) * 128; }
  else { b = i >> 3; qpos0 = 0; h = i & 7; }
  q0 = latq ? b * SEQ + qpos0 : NLAT + b * CTXL + qpos0;
  if (KIND == 0 || KIND == 5) {
    u16* DQ = (u16*)(p.ws + OFF_DQ); const u16* DKb = (const u16*)(p.ws + OFF_DK); const u16* DVb = (const u16*)(p.ws + OFF_DV);
    const float M2 = cst[3] * LOG2E;
#define ATTN_DIF(SH, MM) attn_block<64, 128, 128, AM_DENSE, true, (KIND == 0 ? DQB : 1), SH>(DQ + (size_t)q0 * 512 + h * 128, 512, DKb + h * 128, 512, DVb + h * 128, 512, (u16*)(p.ws + ys_off(1)) + (size_t)q0 * 512 + h * 128, 512, \
        b, latq, qpos0, MM, 0.f, nullptr, cst[0], p.in[I_SUBLN] + l * 128, 1.f - cst[1], lds)
    if (M2 > 64.f) ATTN_DIF(true, M2); else ATTN_DIF(false, 0.f);
#undef ATTN_DIF
  } else if (KIND == 1 || KIND == 7) {
    const u16* MQ = (const u16*)(p.ws + OFF_MQ); const u16* MK = (const u16*)(p.ws + OFF_MK); const u16* MV = (const u16*)(p.ws + OFF_MV);
    const float M2 = cst[5] * LOG2E;
#define ATTN_MLA(SH, MM) attn_block<96, 96, 64, AM_DENSE, false, (KIND == 1 ? 2 : 1), SH>(MQ + (size_t)q0 * 768 + h * 96, 768, MK + h * 96, 768, MV + h * 64, 512, (u16*)(p.ws + ys_off(3)) + (size_t)q0 * 512 + h * 64, 512, \
        b, latq, qpos0, MM, 0.f, nullptr, 0.f, nullptr, 0.f, lds)
    if (M2 > 64.f) ATTN_MLA(true, M2); else ATTN_MLA(false, 0.f);
#undef ATTN_MLA
  } else if (KIND == 2) {
    u16* NQ = (u16*)(p.ws + OFF_NQ); const u16* NK = (const u16*)(p.ws + OFF_NK); const u16* NV = (const u16*)(p.ws + OFF_NV);
    const float M2 = (cst[4] + cst[8 + h]) * LOG2E;
#define ATTN_NAT(SH, MM) attn_block<64, 64, 64, AM_NAT, false, AQB, SH>(NQ + (size_t)q0 * 512 + h * 64, 512, NK + h * 64, 512, NV + h * 64, 512, (u16*)(p.ws + ys_off(2)) + (size_t)q0 * 512 + h * 64, 512, \
        b, true, qpos0, MM, 0.f, p.in[I_RPB] + (size_t)(l * 8 + h) * 465, 0.f, nullptr, 0.f, lds)
    if (M2 > 64.f) ATTN_NAT(true, M2); else ATTN_NAT(false, 0.f);
#undef ATTN_NAT
  } else if (KIND == 6) {
    u16* NQ = (u16*)(p.ws + OFF_NQ); const u16* NK = (const u16*)(p.ws + OFF_NK); const u16* NV = (const u16*)(p.ws + OFF_NV);
    const float M2 = cst[4] * LOG2E;
#define ATTN_NATC(SH, MM) attn_block<64, 64, 64, AM_DENSE, false, AQB, SH>(NQ + (size_t)q0 * 512 + h * 64, 512, NK + h * 64, 512, NV + h * 64, 512, (u16*)(p.ws + ys_off(2)) + (size_t)q0 * 512 + h * 64, 512, \
        b, false, qpos0, MM, 0.f, nullptr, 0.f, nullptr, 0.f, lds)
    if (M2 > 64.f) ATTN_NATC(true, M2); else ATTN_NATC(false, 0.f);
#undef ATTN_NATC
  } else {
    u16* WQ = (u16*)(p.ws + OFF_WQ); const u16* WK = (const u16*)(p.ws + OFF_WK); const u16* WV = (const u16*)(p.ws + OFF_WV);
    const float sk = p.in[I_SINK][l * 8 + h]; const float M = fmaxf(cst[2], sk); const float M2 = M * LOG2E;
#define ATTN_WIN(SH, MM) attn_block<64, 64, 64, AM_WIN, false, AQB, SH>(WQ + (size_t)q0 * 512 + h * 64, 512, WK + (h >> 2) * 64, 128, WV + (h >> 2) * 64, 128, (u16*)(p.ws + ys_off(0)) + (size_t)q0 * 512 + h * 64, 512, \
        b, latq, qpos0, MM, fexp2(sk * LOG2E - MM), nullptr, 0.f, nullptr, 0.f, lds)
    if (M2 > 64.f) ATTN_WIN(true, M2); else ATTN_WIN(false, 0.f);
#undef ATTN_WIN
  }
}
template <int KIND>
DEVI void p4_loop(CPR p, int l, int n, int start, char* lds) {
  for (int rep = 0; rep < 1 + ((REP_KIND >> KIND) & 1); ++rep)
    for (int idx = (blockIdx.x + start) % gridDim.x; idx < n; idx += gridDim.x) {
      int it = idx;
      if (KIND < 4) {
        constexpr int Q = (KIND == 0) ? 64 / DQB : (KIND == 1 ? 16 : 32);
        const int x = idx & 7, y = idx >> 3; it = (x + 8 * (y / Q)) * Q + (y % Q);
      }
      p4_item<KIND>(p, l, it, lds);
    }
}
DEVI void phase4(CPR p, int l, char* lds) {
  p4_loop<0>(p, l, 512 / DQB, 0, lds);
  p4_loop<1>(p, l, 256, 0, lds);
  p4_loop<2>(p, l, 512, 0, lds);
  p4_loop<3>(p, l, 512, 0, lds);
  if (l == 0) {
    p4_loop<4>(p, l, 16, 0, lds);
    p4_loop<5>(p, l, 16, gridDim.x - 16, lds);
    p4_loop<6>(p, l, 16, gridDim.x - 32, lds);
    p4_loop<7>(p, l, 16, gridDim.x - 48, lds);
  }
}

DEVI void p5_item64(CPR p, int l, int item, char* lds) {
  const int tid = TID(), lane = tid & 63, wave = tid >> 6, wm = wave >> 1, wn = wave & 1;
  const int mt = item >> 4, dt = item & 15;
  const u16* H = (const u16*)(p.ws + OFF_H);
  const char* wt = p.ws + OFF_WT + (size_t)l * WT_LAYER;
  f32x4 m[2][4];
#pragma unroll
  for (int a = 0; a < 2; ++a)
#pragma unroll
    for (int b = 0; b < 4; ++b) m[a][b] = f32x4{0, 0, 0, 0};
  static_assert(OFF_DQ == OFF_WQ + SZ512 && OFF_NQ == OFF_WQ + 2 * SZ512 && OFF_YD == OFF_WQ + 3 * SZ512, "ys buffers must be contiguous");
#pragma unroll 1
  for (int n = 0; n < 4; ++n) {
    if (!((BRANCH_MASK >> n) & 1)) continue;
    f32x4 y[2][4]; unsigned g8[2][4];
#pragma unroll
    for (int a = 0; a < 2; ++a)
#pragma unroll
      for (int b = 0; b < 4; ++b) { y[a][b] = f32x4{0, 0, 0, 0};
        g8[a][b] = *(const unsigned*)(gate_row(p, l, mt * BM + wm * 64 + b * 16 + (lane & 15)) + n * 1024 + dt * 64 + wn * 32 + a * 16 + (lane >> 4) * 4); }
    const u16* ys = (const u16*)(p.ws + ys_off(n));
    gemm_tile<64, 4, 2, 3>(y, [&](int r) { return ys + (size_t)(mt * BM + r) * 512; }, (const u16*)(wt + WT_WB) + (size_t)(n * 1024 + dt * 64) * 512, 512, 512, lds, tid);
#pragma unroll
    for (int a = 0; a < 2; ++a)
#pragma unroll
      for (int b = 0; b < 4; ++b)
#pragma unroll
        for (int r = 0; r < 4; ++r) m[a][b][r] += (float)((g8[a][b] >> (8 * r)) & 255u) * y[a][b][r];
  }
  u16* M = (u16*)(p.ws + OFF_M);
#pragma unroll
  for (int mi = 0; mi < 4; ++mi) { const int row = mt * BM + wm * 64 + mi * 16 + (lane & 15);
#pragma unroll
    for (int ni = 0; ni < 2; ++ni) st4(M + (size_t)row * 1024 + dt * 64 + wn * 32 + ni * 16 + (lane >> 4) * 4, m[ni][mi][0] * (1.f / 255.f), m[ni][mi][1] * (1.f / 255.f), m[ni][mi][2] * (1.f / 255.f), m[ni][mi][3] * (1.f / 255.f)); }
}

DEVI void p5_item128(CPR p, int l, int mt, int nt, char* lds) {
  const int tid = TID(), lane = tid & 63, wave = tid >> 6, wm = wave >> 1, wn = wave & 1;
  const u16* H = (const u16*)(p.ws + OFF_H);
  const char* wt = p.ws + OFF_WT + (size_t)l * WT_LAYER;
  f32x4 m[4][4];
#pragma unroll
  for (int a = 0; a < 4; ++a)
#pragma unroll
    for (int b = 0; b < 4; ++b) m[a][b] = f32x4{0, 0, 0, 0};
#pragma unroll 1
  for (int n = 0; n < 4; ++n) {
    if (!((BRANCH_MASK >> n) & 1)) continue;
    unsigned g8[4][4];
    f32x4 y[4][4];
#pragma unroll
    for (int a = 0; a < 4; ++a)
#pragma unroll
      for (int b = 0; b < 4; ++b) { y[a][b] = f32x4{0, 0, 0, 0};
        g8[a][b] = *(const unsigned*)(gate_row(p, l, mt * BM + wm * 64 + b * 16 + (lane & 15)) + n * 1024 + nt * 128 + wn * 64 + a * 16 + (lane >> 4) * 4); }
    const u16* ys = (const u16*)(p.ws + ys_off(n));
    gemm_tile<128, 4, 2>(y, [&](int r) { return ys + (size_t)(mt * BM + r) * 512; }, (const u16*)(wt + WT_WB) + (size_t)(n * 1024 + nt * 128) * 512, 512, 512, lds, tid);
#pragma unroll
    for (int a = 0; a < 4; ++a)
#pragma unroll
      for (int b = 0; b < 4; ++b) {
        const unsigned gw = g8[a][b];
        m[a][b][0] += (float)(gw & 255u) * y[a][b][0]; m[a][b][1] += (float)((gw >> 8) & 255u) * y[a][b][1];
        m[a][b][2] += (float)((gw >> 16) & 255u) * y[a][b][2]; m[a][b][3] += (float)(gw >> 24) * y[a][b][3];
      }
  }
  u16* M = (u16*)(p.ws + OFF_M);
#pragma unroll
  for (int mi = 0; mi < 4; ++mi) { const int row = mt * BM + wm * 64 + mi * 16 + (lane & 15);
#pragma unroll
    for (int ni = 0; ni < 4; ++ni) st4(M + (size_t)row * 1024 + nt * 128 + wn * 64 + ni * 16 + (lane >> 4) * 4, m[ni][mi][0] * (1.f / 255.f), m[ni][mi][1] * (1.f / 255.f), m[ni][mi][2] * (1.f / 255.f), m[ni][mi][3] * (1.f / 255.f)); }
}
DEVI void phase5(CPR p, int l, char* lds) {
  { const int ns = xcd_slots(NLAT / BM, 8); for (int it = blockIdx.x; it < ns; it += gridDim.x) { int mt, nt; if (xcd_tile(it, NLAT / BM, 8, mt, nt)) p5_item128(p, l, mt, nt, lds); } }
  if (l == 0) for (int it = blockIdx.x; it < 2 * 16; it += gridDim.x) p5_item64(p, l, (NLAT / BM) * 16 + it, lds);
}

DEVI void p6_item(CPR p, int l, int item, char* lds) {
  const int tid = TID(), lane = tid & 63, wave = __builtin_amdgcn_readfirstlane(tid >> 6), wr = wave >> 2, wc = wave & 3;
  const int mt = item >> 2, nt2 = item & 3;
  const u16* M = (const u16*)(p.ws + OFF_M) + (size_t)mt * BM * 1024;
  f32x4 acc[2][2][4][2];
#pragma unroll
  for (int a = 0; a < 2; ++a)
#pragma unroll
    for (int b = 0; b < 2; ++b)
#pragma unroll
      for (int c = 0; c < 4; ++c) { acc[a][b][c][0] = f32x4{0, 0, 0, 0}; acc[a][b][c][1] = f32x4{0, 0, 0, 0}; }
  gemm256<false, 0>(acc, (const u16*)(p.ws + OFF_WT + (size_t)l * WT_LAYER + WT_WO) + (size_t)nt2 * 256 * 1024, 1024, M, [&](int r) { return r * 1024; }, 1024, lds, tid);
  const float* mods = (const float*)(p.ws + OFF_MODS);
#pragma unroll
  for (int bj = 0; bj < 2; ++bj)
#pragma unroll
    for (int n = 0; n < 2; ++n) {
      const int row = mt * BM + bj * 128 + wc * 32 + n * 16 + (lane & 15); const bool lat = row < NLAT; const int ridx = lat ? (row >> 13) : 2;
      const float* g1 = mods + (size_t)(l * 3 + ridx) * 6144 + 2048;
      const float* src; float* dst;
      if (lat) { src = (l == 0 ? p.in[I_X] : p.out) + (size_t)row * 1024; dst = p.out + (size_t)row * 1024; }
      else { src = (l == 0 ? p.in[I_CTX] : (const float*)(p.ws + OFF_XC)) + (size_t)(row - NLAT) * 1024; dst = (float*)(p.ws + OFF_XC) + (size_t)(row - NLAT) * 1024; }
#pragma unroll
      for (int ai = 0; ai < 2; ++ai)
#pragma unroll
        for (int m = 0; m < 4; ++m) { const int col = nt2 * 256 + ai * 128 + wr * 64 + m * 16 + (lane >> 4) * 4;
          float4 x = *(const float4*)(src + col), g = *(const float4*)(g1 + col);
          x.x += g.x * acc[ai][bj][m][n][0]; x.y += g.y * acc[ai][bj][m][n][1]; x.z += g.z * acc[ai][bj][m][n][2]; x.w += g.w * acc[ai][bj][m][n][3];
          *(float4*)(dst + col) = x; }
    }
}
DEVI void p6_ctx_item(CPR p, int l, int item, char* lds) {
  const int tid = TID(), lane = tid & 63, wave = tid >> 6, wm = wave >> 1, wn = wave & 1;
  const int mt = NLAT / BM + (item >> 4), dt = item & 15;
  const u16* M = (const u16*)(p.ws + OFF_M);
  f32x4 acc[2][4];
#pragma unroll
  for (int a = 0; a < 2; ++a)
#pragma unroll
    for (int b = 0; b < 4; ++b) acc[a][b] = f32x4{0, 0, 0, 0};
  gemm_tile<64, 4, 2, 3>(acc, [&](int r) { return M + (size_t)(mt * BM + r) * 1024; }, (const u16*)(p.ws + OFF_WT + (size_t)l * WT_LAYER + WT_WO) + (size_t)dt * 64 * 1024, 1024, 1024, lds, tid);
  const float* g1 = (const float*)(p.ws + OFF_MODS) + (size_t)(l * 3 + 2) * 6144 + 2048;
#pragma unroll
  for (int mi = 0; mi < 4; ++mi) { const int row = mt * BM + wm * 64 + mi * 16 + (lane & 15);
    const float* src = (l == 0 ? p.in[I_CTX] : (const float*)(p.ws + OFF_XC)) + (size_t)(row - NLAT) * 1024; float* dst = (float*)(p.ws + OFF_XC) + (size_t)(row - NLAT) * 1024;
#pragma unroll
    for (int ni = 0; ni < 2; ++ni) { const int col = dt * 64 + wn * 32 + ni * 16 + (lane >> 4) * 4;
      float4 x = *(const float4*)(src + col), g = *(const float4*)(g1 + col);
      x.x += g.x * acc[ni][mi][0]; x.y += g.y * acc[ni][mi][1]; x.z += g.z * acc[ni][mi][2]; x.w += g.w * acc[ni][mi][3];
      *(float4*)(dst + col) = x; } }
}

DEVI void phase7(CPR p, int l, char* lds) {
  const int tid = TID(), lane = tid & 63, wave = tid >> 6;
  const float* mods = (const float*)(p.ws + OFF_MODS);
  u16* H = (u16*)(p.ws + OFF_H);
  int* cnt = (int*)(p.ws + OFF_CNT) + l * 16; int* list = (int*)(p.ws + OFF_LIST); float* tokw = (float*)(p.ws + OFF_TOKW);
  const float* rb = p.in[I_RB];
  const int nrows = (l == 0) ? NROW : NLAT;
  const int rpb = (nrows + (int)gridDim.x - 1) / (int)gridDim.x;
  const int row_lo = blockIdx.x * rpb, row_hi = (row_lo + rpb < nrows) ? row_lo + rpb : nrows;
  float* rwl = (float*)lds;
  int* sel = (int*)(lds + 65536);
  {
    const float4* src = (const float4*)(p.ws + OFF_RWT);
#pragma unroll
    for (int i = 0; i < 8; ++i) ((float4*)rwl)[tid + NTHR * i] = src[tid + NTHR * i];
  }
  __syncthreads();
  conv_run_w(48, 48 * 128, [&](int d) { return moe_desc(p, l, d); }, lds + 69632, 4, 4);
  if (wave < 4)
  for (int row = row_lo + wave; row < row_hi; row += 4) {
    const bool lat = row < NLAT; const int ridx = lat ? (row >> 13) : 2;
    const float* src = lat ? p.out + (size_t)row * 1024 : (const float*)(p.ws + OFF_XC) + (size_t)(row - NLAT) * 1024;
    float4 v[4];
#pragma unroll
    for (int j = 0; j < 4; ++j) v[j] = *(const float4*)(src + lane * 4 + 256 * j);
    float ss = 0;
#pragma unroll
    for (int j = 0; j < 4; ++j) ss += v[j].x * v[j].x + v[j].y * v[j].y + v[j].z * v[j].z + v[j].w * v[j].w;
    ss = wave_sum(ss);
    const float rs = rsqrtf(ss * (1.f / 1024.f) + EPS);
    const float* md = mods + (size_t)(l * 3 + ridx) * 6144; const float* ng = p.in[I_N2G] + l * 1024;
#pragma unroll
    for (int j = 0; j < 4; ++j) {
      const int k = lane * 4 + 256 * j;
      float4 g = *(const float4*)(ng + k), sh = *(const float4*)(md + 3072 + k), sc = *(const float4*)(md + 4096 + k);
      v[j].x = v[j].x * rs * g.x * (1.f + sc.x) + sh.x; v[j].y = v[j].y * rs * g.y * (1.f + sc.y) + sh.y;
      v[j].z = v[j].z * rs * g.z * (1.f + sc.z) + sh.z; v[j].w = v[j].w * rs * g.w * (1.f + sc.w) + sh.w;
      st4(H + (size_t)row * 1024 + k, v[j].x, v[j].y, v[j].z, v[j].w);
    }
    float pl[16];
#pragma unroll
    for (int e = 0; e < 16; ++e) {
      float a = 0.f;
#pragma unroll
      for (int j = 0; j < 4; ++j) { const float4 w = *(const float4*)(rwl + e * 1024 + lane * 4 + 256 * j); a += v[j].x * w.x + v[j].y * w.y + v[j].z * w.z + v[j].w * w.w; }
      pl[e] = a;
    }
    float w8[8], w4[4], w2[2], w1;
    { const bool up = (lane & 32) != 0;
#pragma unroll
      for (int i = 0; i < 8; ++i) { const float snd = up ? pl[i] : pl[8 + i], kp = up ? pl[8 + i] : pl[i]; w8[i] = kp + shx(snd, 32); } }
    { const bool up = (lane & 16) != 0;
#pragma unroll
      for (int i = 0; i < 4; ++i) { const float snd = up ? w8[i] : w8[4 + i], kp = up ? w8[4 + i] : w8[i]; w4[i] = kp + shx(snd, 16); } }
    { const bool up = (lane & 8) != 0;
#pragma unroll
      for (int i = 0; i < 2; ++i) { const float snd = up ? w4[i] : w4[2 + i], kp = up ? w4[2 + i] : w4[i]; w2[i] = kp + shx(snd, 8); } }
    { const bool up = (lane & 4) != 0; const float snd = up ? w2[0] : w2[1], kp = up ? w2[1] : w2[0]; w1 = kp + shx(snd, 4); }
    w1 += shx(w1, 2); w1 += shx(w1, 1);
    float lg[16];
#pragma unroll
    for (int e = 0; e < 16; ++e) lg[e] = shl_(w1, 4 * e);
    float sc_[16], bi[16];
#pragma unroll
    for (int e = 0; e < 16; ++e) { sc_[e] = 1.f / (1.f + expf(-lg[e])); bi[e] = sc_[e] + rb[e]; }
    float best_gs = -3.0e38f; int e1 = 0, e2 = 1; float s1 = 0.f, s2 = 0.f;
#pragma unroll
    for (int g = 0; g < 4; ++g) {
      const float a = bi[4 * g], b = bi[4 * g + 1], c = bi[4 * g + 2], d = bi[4 * g + 3];
      const float h1 = fmaxf(a, b), l1 = fminf(a, b), h2 = fmaxf(c, d), l2 = fminf(c, d);
      const float m1 = fmaxf(h1, h2), m2 = fmaxf(fminf(h1, h2), fmaxf(l1, l2));
      const float gs = m1 + m2;
      int i1 = 0; float v1 = a;
      if (b > v1) { v1 = b; i1 = 1; } if (c > v1) { v1 = c; i1 = 2; } if (d > v1) { v1 = d; i1 = 3; }
      int i2 = -1; float v2 = -3.0e38f;
      if (i1 != 0 && a > v2) { v2 = a; i2 = 0; } if (i1 != 1 && b > v2) { v2 = b; i2 = 1; } if (i1 != 2 && c > v2) { v2 = c; i2 = 2; } if (i1 != 3 && d > v2) { v2 = d; i2 = 3; }
      const float sa = sc_[4 * g], sb = sc_[4 * g + 1], scc = sc_[4 * g + 2], sd = sc_[4 * g + 3];
      const float t1 = i1 == 0 ? sa : (i1 == 1 ? sb : (i1 == 2 ? scc : sd));
      const float t2 = i2 == 0 ? sa : (i2 == 1 ? sb : (i2 == 2 ? scc : sd));
      if (gs > best_gs) { best_gs = gs; e1 = 4 * g + i1; e2 = 4 * g + i2; s1 = t1; s2 = t2; }
    }
    if (lane == 0) {
      const float inv = 1.f / (s1 + s2);
      sel[(row - row_lo) * 2] = e1; sel[(row - row_lo) * 2 + 1] = e2;
      tokw[row * 2] = s1 * inv; tokw[row * 2 + 1] = s2 * inv;
    }
  }
  __syncthreads();
  if (tid < 16) {
    const int e = tid, n = row_hi - row_lo; int c = 0;
    for (int i = 0; i < 2 * n; ++i) c += (sel[i] == e) ? 1 : 0;
    if (c > 0) {
      int pos = atomicAdd(&cnt[e], c);
      int* dst = list + (size_t)e * LCAP;
      for (int i = 0; i < 2 * n; ++i) if (sel[i] == e) dst[pos++] = (row_lo + (i >> 1)) * 2 + (i & 1);
    }
  }
  __syncthreads();
}

struct ExpTile { int e, mt, rowbase, count, ntiles; };
DEVI ExpTile exp_find(const int* cnt, int tile) {
  ExpTile r; r.e = 0; r.mt = 0; r.rowbase = 0; r.count = 0; int tacc = 0, racc = 0;
#pragma unroll
  for (int i = 0; i < 16; ++i) { const int c = cnt[i]; const int n = (c + BM - 1) / BM;
    if (tile >= tacc && tile < tacc + n) { r.e = i; r.mt = tile - tacc; r.rowbase = racc; r.count = c; }
    tacc += n; racc += c; }
  r.ntiles = tacc;
  r.e = __builtin_amdgcn_readfirstlane(r.e); r.mt = __builtin_amdgcn_readfirstlane(r.mt); r.rowbase = __builtin_amdgcn_readfirstlane(r.rowbase); r.count = __builtin_amdgcn_readfirstlane(r.count); r.ntiles = __builtin_amdgcn_readfirstlane(r.ntiles);
  return r;
}
DEVI bool moe_split(int ntot, int& nfull) { const int G = gridDim.x, rem = ntot % G; const bool sp = rem > 0 && ntot > G && rem * 4 <= 2 * G; nfull = sp ? ntot - rem : ntot; return sp; }
DEVI void p8_piece(CPR p, int l, int item, int g, char* lds) {
  const int tid = TID(), lane = tid & 63, wave = tid >> 6;
  const int* cnt = (const int*)(p.ws + OFF_CNT) + l * 16; const int* list = (const int*)(p.ws + OFF_LIST);
  const u16* H = (const u16*)(p.ws + OFF_H); u16* HE = (u16*)(p.ws + OFF_HEXP);
  const ExpTile et = exp_find(cnt, item >> 2); const int nt2 = item & 3;
  const int* lst = list + (size_t)et.e * LCAP;
  f32x4 acc[4][2];
#pragma unroll
  for (int a = 0; a < 4; ++a) { acc[a][0] = f32x4{0, 0, 0, 0}; acc[a][1] = f32x4{0, 0, 0, 0}; }
  gemm_tile<64, 8, 1, 3>(acc, [&](int r) { int s = et.mt * BM + r; s = s < et.count ? s : 0; return H + (size_t)(lst[s] >> 1) * 1024; },
                         (const u16*)(p.ws + OFF_MOEW13) + (size_t)(et.e * 1024 + nt2 * 256 + g * 64) * 1024, 1024, 1024, lds, tid);
#pragma unroll
  for (int mi = 0; mi < 2; ++mi) { const int s = et.mt * BM + wave * 32 + mi * 16 + (lane & 15);
    if (s < et.count) {
#pragma unroll
      for (int ni = 0; ni < 2; ++ni) { float hv[4];
#pragma unroll
        for (int r = 0; r < 4; ++r) { const float a = acc[ni][mi][r], b = acc[ni + 2][mi][r]; hv[r] = a * sigmoidf_(a) * b; }
        st4(HE + (size_t)(et.rowbase + s) * 512 + nt2 * 128 + g * 32 + ni * 16 + (lane >> 4) * 4, hv[0], hv[1], hv[2], hv[3]); }
    } }
}
DEVI void p9_piece(CPR p, int l, int item, int g, char* lds) {
  const int tid = TID(), lane = tid & 63, wave = tid >> 6;
  const int* cnt = (const int*)(p.ws + OFF_CNT) + l * 16; const int* list = (const int*)(p.ws + OFF_LIST);
  const u16* HE = (const u16*)(p.ws + OFF_HEXP); u16* YB = (u16*)(p.ws + OFF_YBUF);
  const ExpTile et = exp_find(cnt, item >> 2); const int nt2 = item & 3;
  const int* lst = list + (size_t)et.e * LCAP;
  f32x4 acc[4][2];
#pragma unroll
  for (int a = 0; a < 4; ++a) { acc[a][0] = f32x4{0, 0, 0, 0}; acc[a][1] = f32x4{0, 0, 0, 0}; }
  gemm_tile<64, 8, 1, 3>(acc, [&](int r) { return HE + (size_t)(et.rowbase + et.mt * BM + r) * 512; },
                         (const u16*)(p.ws + OFF_MOEW2) + (size_t)(et.e * 1024 + nt2 * 256 + g * 64) * 512, 512, 512, lds, tid);
#pragma unroll
  for (int mi = 0; mi < 2; ++mi) { const int s = et.mt * BM + wave * 32 + mi * 16 + (lane & 15);
    if (s < et.count) { const int a = lst[s];
#pragma unroll
      for (int ni = 0; ni < 4; ++ni) st4(YB + (size_t)a * 1024 + nt2 * 256 + g * 64 + ni * 16 + (lane >> 4) * 4, acc[ni][mi][0], acc[ni][mi][1], acc[ni][mi][2], acc[ni][mi][3]); }
  }
}
DEVI void phase8(CPR p, int l, char* lds) {
  const int tid = TID(), lane = tid & 63, wave = __builtin_amdgcn_readfirstlane(tid >> 6), wr = wave >> 2, wc = wave & 3;
  const int* cnt = (const int*)(p.ws + OFF_CNT) + l * 16; const int* list = (const int*)(p.ws + OFF_LIST);
  const u16* H = (const u16*)(p.ws + OFF_H); u16* HE = (u16*)(p.ws + OFF_HEXP);
  const int ntot = exp_find(cnt, -1).ntiles * 4; int nfull; const bool split = moe_split(ntot, nfull);
  if (split) for (int pc = blockIdx.x; pc < ((ntot - nfull + 7) >> 3) * 32; pc += gridDim.x) { const int io = ((pc >> 5) << 3) + (pc & 7);
    if (io < ntot - nfull) p8_piece(p, l, nfull + io, (pc >> 3) & 3, lds); }
  for (int item = blockIdx.x; item < nfull; item += gridDim.x) {
    const ExpTile et = exp_find(cnt, item >> 2); const int nt2 = item & 3;
    const int* lst = list + (size_t)et.e * LCAP;
    f32x4 acc[2][2][4][2];
#pragma unroll
    for (int a = 0; a < 2; ++a)
#pragma unroll
      for (int b = 0; b < 2; ++b)
#pragma unroll
        for (int c = 0; c < 4; ++c) { acc[a][b][c][0] = f32x4{0, 0, 0, 0}; acc[a][b][c][1] = f32x4{0, 0, 0, 0}; }
    gemm256<true, 0>(acc, (const u16*)(p.ws + OFF_MOEW13) + (size_t)(et.e * 1024 + nt2 * 256) * 1024, 1024, H,
            [&](int r) { int s = et.mt * BM + r; s = s < et.count ? s : 0; return (lst[s] >> 1) * 1024; }, 1024, lds, tid);
#pragma unroll
    for (int bj = 0; bj < 2; ++bj)
#pragma unroll
      for (int n = 0; n < 2; ++n) { const int s = et.mt * BM + bj * 128 + wc * 32 + n * 16 + (lane & 15);
        if (s < et.count) {
#pragma unroll
          for (int ai = 0; ai < 2; ++ai)
#pragma unroll
            for (int m = 0; m < 2; ++m) { float hv[4];
#pragma unroll
              for (int r = 0; r < 4; ++r) { const float a = acc[ai][bj][m][n][r], b = acc[ai][bj][m + 2][n][r]; hv[r] = a * sigmoidf_(a) * b; }
              st4(HE + (size_t)(et.rowbase + s) * 512 + nt2 * 128 + ai * 64 + wr * 32 + m * 16 + (lane >> 4) * 4, hv[0], hv[1], hv[2], hv[3]); }
        } }
  }
}
DEVI void phase9(CPR p, int l, char* lds) {
  const int tid = TID(), lane = tid & 63, wave = __builtin_amdgcn_readfirstlane(tid >> 6), wr = wave >> 2, wc = wave & 3;
  const int* cnt = (const int*)(p.ws + OFF_CNT) + l * 16; const int* list = (const int*)(p.ws + OFF_LIST);
  const u16* HE = (const u16*)(p.ws + OFF_HEXP); u16* YB = (u16*)(p.ws + OFF_YBUF);
  const int ntot = exp_find(cnt, -1).ntiles * 4; int nfull; const bool split = moe_split(ntot, nfull);
  if (split) for (int pc = blockIdx.x; pc < ((ntot - nfull + 7) >> 3) * 32; pc += gridDim.x) { const int io = ((pc >> 5) << 3) + (pc & 7);
    if (io < ntot - nfull) p9_piece(p, l, nfull + io, (pc >> 3) & 3, lds); }
  for (int item = blockIdx.x; item < nfull; item += gridDim.x) {
    const ExpTile et = exp_find(cnt, item >> 2); const int nt2 = item & 3;
    const int* lst = list + (size_t)et.e * LCAP;
    f32x4 acc[2][2][4][2];
#pragma unroll
    for (int a = 0; a < 2; ++a)
#pragma unroll
      for (int b = 0; b < 2; ++b)
#pragma unroll
        for (int c = 0; c < 4; ++c) { acc[a][b][c][0] = f32x4{0, 0, 0, 0}; acc[a][b][c][1] = f32x4{0, 0, 0, 0}; }
    gemm256<false, 0>(acc, (const u16*)(p.ws + OFF_MOEW2) + (size_t)(et.e * 1024 + nt2 * 256) * 512, 512, HE + (size_t)(et.rowbase + et.mt * BM) * 512,
            [&](int r) { return r * 512; }, 512, lds, tid);
#pragma unroll
    for (int bj = 0; bj < 2; ++bj)
#pragma unroll
      for (int n = 0; n < 2; ++n) { const int s = et.mt * BM + bj * 128 + wc * 32 + n * 16 + (lane & 15);
        if (s < et.count) { const int a = lst[s];
#pragma unroll
          for (int ai = 0; ai < 2; ++ai)
#pragma unroll
            for (int m = 0; m < 4; ++m) st4(YB + (size_t)a * 1024 + nt2 * 256 + ai * 128 + wr * 64 + m * 16 + (lane >> 4) * 4, acc[ai][bj][m][n][0], acc[ai][bj][m][n][1], acc[ai][bj][m][n][2], acc[ai][bj][m][n][3]); }
      }
  }
}

DEVI void run_stage(KPTR kp, int stage, char* lds) {
  asm volatile("" : "+s"(kp));
  CPR p = *kp;
  if (stage == 0) { phase0(p, lds); return; }
  if (stage == 19) { phase_final(p); return; }
  if (stage == 20) { const u16* buf = (const u16*)(p.ws + DUMP_OFF);
    for (size_t i = (size_t)blockIdx.x * NTHR + threadIdx.x; i < (size_t)NLAT * 1024; i += (size_t)gridDim.x * NTHR) { size_t row = i >> 10; int c = (int)(i & 1023) % DUMP_LD; p.out[i] = bf2f(buf[row * DUMP_LD + c]); }
    return; }
  const int l = (stage - 1) / 9, ph = (stage - 1) % 9 + 1;
  const int nM = (l == 0) ? NROW / BM : NLAT / BM;
  if (PH_ONLY && ph != PH_ONLY) return;
  switch (PH_ONLY ? PH_ONLY : ph) {
    case 1: phase1(p, l, lds); break;
    case 2: phase2(p, l, lds); break;
    case 3: for (int it = blockIdx.x; it < (NROW / BM) * 16; it += gridDim.x) p3_item(p, l, it, lds); break;
    case 4: phase4(p, l, lds); break;
    case 5: phase5(p, l, lds); break;
    case 6: for (int it = blockIdx.x; it < (NLAT / BM) * 4; it += gridDim.x) p6_item(p, l, it, lds);
      if (l == 0) for (int it = blockIdx.x; it < 32; it += gridDim.x) p6_ctx_item(p, l, it, lds);
      break;
    case 7: phase7(p, l, lds); break;
    case 8: phase8(p, l, lds); break;
    default: phase9(p, l, lds); break;
  }
}

#ifndef EXTRA_BARS
#define EXTRA_BARS 0
#endif
#ifndef REP_ATTN
#define REP_ATTN 0
#endif
#ifndef USE_CG_SYNC
#define USE_CG_SYNC 0
#endif
#ifndef REP_MASK
#define REP_MASK 0u
#endif
#if ONE_LAUNCH
#define XB_TMO      128
#define XB_XCNT(j)  (256  + 64 * (j))
#define XB_XSUB(j)  (1280 + 64 * (j))
#define XB_XGEN(j)  (2304 + 64 * (j))
#define XB_TOP      3328
#define XB_TOPGEN   3392
#define XCD_BAR_WORDS 3456
#define XB_SPIN_CAP (1u << 20)
DEVI unsigned xb_ld(unsigned* p)              { return __hip_atomic_load(p, __ATOMIC_RELAXED, __HIP_MEMORY_SCOPE_AGENT); }
DEVI unsigned xb_add(unsigned* p, unsigned v) { return __hip_atomic_fetch_add(p, v, __ATOMIC_RELAXED, __HIP_MEMORY_SCOPE_AGENT); }
DEVI unsigned xb_xcc_id() { return (unsigned)__builtin_amdgcn_s_getreg((3 << 11) | 20) & 0xFu; }
#define XB_SPIN(cond, bar) do { unsigned _sp = 0; while (cond) { __builtin_amdgcn_s_sleep(1); \
    if ((++_sp & 255u) == 0u) { if (xb_ld(&(bar)[XB_TMO])) break; if (_sp > XB_SPIN_CAP) { atomicAdd(&(bar)[XB_TMO], 1u); break; } } } } while (0)
DEVI void xcd_barrier_complete(unsigned* bar, unsigned x, unsigned& nloc, unsigned& nx) {
  const unsigned G = gridDim.x;
  unsigned sum, cnt, mine, sp = 0u;
  for (;;) {
    sum = 0u; cnt = 0u; mine = 0u;
#pragma unroll
    for (unsigned j = 0; j < 16; ++j) { const unsigned c = xb_ld(&bar[XB_XCNT(j)]); sum += c; cnt += (c > 0u) ? 1u : 0u; mine = (j == x) ? c : mine; }
    if (sum == G) break;
    __builtin_amdgcn_s_sleep(1);
    if ((++sp & 255u) == 0u) { if (xb_ld(&bar[XB_TMO])) break; if (sp > XB_SPIN_CAP) { atomicAdd(&bar[XB_TMO], 1u); break; } }
  }
  nloc = mine > 0u ? mine : 1u; nx = cnt > 0u ? cnt : 1u;
}
DEVI void xcd_barrier(unsigned* bar, unsigned x, volatile LAS unsigned* st) {
  asm volatile("s_waitcnt vmcnt(0)" ::: "memory");
  __syncthreads();
  if (TID() == 0) {
    __builtin_amdgcn_s_waitcnt(0);
    unsigned nloc = st[0], nx = st[1];
    if (nloc == 0u) { xcd_barrier_complete(bar, x, nloc, nx); st[0] = nloc; st[1] = nx; }
    const unsigned old = xb_add(&bar[XB_XSUB(x)], 1u);
    const unsigned gen = old / nloc;
    if (old + 1u == (gen + 1u) * nloc) {
      __builtin_amdgcn_fence(__ATOMIC_RELEASE, "agent");
      asm volatile("s_waitcnt vmcnt(0)" ::: "memory");
      const unsigned og = xb_add(&bar[XB_TOP], 1u);
      const unsigned tg = og / nx;
      if (og + 1u == (tg + 1u) * nx) xb_add(&bar[XB_TOPGEN], 1u);
      else XB_SPIN(xb_ld(&bar[XB_TOPGEN]) == tg, bar);
      __builtin_amdgcn_fence(__ATOMIC_ACQUIRE, "agent");
      xb_add(&bar[XB_XGEN(x)], 1u);
      asm volatile("s_waitcnt vmcnt(0)" ::: "memory");
    } else {
      XB_SPIN(xb_ld(&bar[XB_XGEN(x)]) == gen, bar);
      __builtin_amdgcn_fence(__ATOMIC_ACQUIRE, "agent");
      asm volatile("s_waitcnt vmcnt(0)" ::: "memory");
    }
  }
  __syncthreads();
}
__global__ void __launch_bounds__(NTHR, 2) mega_kernel(Params p_) {
  __shared__ __attribute__((aligned(16))) char lds[LDS_BYTES];
  cg::grid_group grid = cg::this_grid();
  unsigned* bar = (unsigned*)(((KPTR)__builtin_amdgcn_kernarg_segment_ptr())->ws + OFF_BAR);
  volatile LAS unsigned* st = (volatile LAS unsigned*)(lds + LDS_BYTES - 16);
  if (threadIdx.x == 0) { st[0] = 0u; st[1] = 0u; }
  tid_init();
  const unsigned xcc = xb_xcc_id();
  if (threadIdx.x == 0) (void)xb_add(&bar[XB_XCNT(xcc)], 1u);
#pragma unroll 1
  for (int stage = 0; stage < 20; ++stage) {
    run_stage((KPTR)__builtin_amdgcn_kernarg_segment_ptr(), stage, lds);
    if (stage == 0 && USE_CG_SYNC) grid.sync();
    else if (stage < 19) { xcd_barrier(bar, xcc, st); for (int e = 0; e < EXTRA_BARS; ++e) xcd_barrier(bar, xcc, st); }
  }
}
#else
__global__ void __launch_bounds__(NTHR, 2) stage_kernel(Params p, int stage) {
  __shared__ __attribute__((aligned(16))) char lds[LDS_BYTES];
  tid_init();
  run_stage((KPTR)__builtin_amdgcn_kernarg_segment_ptr(), stage, lds);
}
#endif

extern "C" void kernel_launch(void* const* d_in, const int* in_sizes, int n_in, void* d_out, int out_size, void* d_ws, size_t ws_size, hipStream_t stream) {
  static int grid_blocks = 0;
  if (grid_blocks == 0) {
    if (n_in != 32 || ws_size < WS_END || out_size != NLAT * 1024) { fprintf(stderr, "kernel_launch: unexpected shapes (n_in %d, ws %zu need %zu, out %d)\n", n_in, ws_size, (size_t)WS_END, out_size); grid_blocks = -1; return; }
    int dev = 0, cus = 0, per_cu = 0;
    hipGetDevice(&dev);
    hipDeviceGetAttribute(&cus, hipDeviceAttributeMultiprocessorCount, dev);
#if ONE_LAUNCH
    hipOccupancyMaxActiveBlocksPerMultiprocessor(&per_cu, mega_kernel, NTHR, 0);
#else
    hipOccupancyMaxActiveBlocksPerMultiprocessor(&per_cu, stage_kernel, NTHR, 0);
#endif
    if (per_cu < 1) per_cu = 1;
    if (per_cu > 1) per_cu = 1;
    grid_blocks = cus * per_cu;
  }
  if (grid_blocks < 0) return;
  Params p{};
  for (int i = 0; i < 32; ++i) p.in[i] = (const float*)d_in[i];
  p.out = (float*)d_out; p.ws = (char*)d_ws;
#if ONE_LAUNCH
  hipMemsetAsync((char*)d_ws + OFF_BAR, 0, 16384, stream);
  void* args[] = {&p};
  hipError_t e = hipLaunchCooperativeKernel((void*)mega_kernel, dim3(grid_blocks), dim3(NTHR), args, 0, stream);
  if (e != hipSuccess) fprintf(stderr, "cooperative launch failed: %s (grid %d)\n", hipGetErrorString(e), grid_blocks);
#else
  for (int s = 0; s < STOP_STAGE; ++s) hipLaunchKernelGGL(stage_kernel, dim3(grid_blocks), dim3(NTHR), 0, stream, p, s);
  if (STOP_STAGE < 20) hipLaunchKernelGGL(stage_kernel, dim3(grid_blocks), dim3(NTHR), 0, stream, p, 20);
#endif
}
```

```cpp
#include <hip/hip_runtime.h>
#include <hip/hip_cooperative_groups.h>
#include <stdint.h>
#include <stdio.h>
namespace cg = cooperative_groups;

#ifndef ONE_LAUNCH
#define ONE_LAUNCH 1
#endif
#ifndef STOP_STAGE
#define STOP_STAGE 20
#endif
#ifndef DUMP_OFF
#define DUMP_OFF OFF_MK
#define DUMP_LD 768
#endif
#ifndef REP_LO
#define REP_LO 0
#define REP_HI -1
#endif
#ifndef REP7
#define REP7 0
#endif
#ifndef OPC
#define OPC 0
#endif
#ifndef REP_KIND
#define REP_KIND 0
#endif
#ifndef NWQB
#define NWQB 2
#endif
#ifndef DQB
#define DQB 2
#endif
#ifndef PH_ONLY
#define PH_ONLY 0
#endif
#ifndef BRANCH_MASK
#define BRANCH_MASK 15
#endif

typedef unsigned short u16;
using bf16x8 = __attribute__((ext_vector_type(8))) short;
using bf16x4 = __attribute__((ext_vector_type(4))) short;
using f32x4  = __attribute__((ext_vector_type(4))) float;
using f32x16 = __attribute__((ext_vector_type(16))) float;
using u32x4  = __attribute__((ext_vector_type(4))) unsigned;
#define DEVI __device__ __forceinline__

constexpr int D = 1024, SEQ = 8192, NB = 2, CTXL = 256;
constexpr int NLAT = NB * SEQ;
constexpr int NROW = NLAT + NB * CTXL;
constexpr int DIN = 8352;
constexpr int NASSIGN = 2 * NROW;
constexpr int LCAP = NROW;
constexpr float EPS = 1e-6f;
constexpr float LOG2E = 1.4426950408889634f;

enum { I_X = 0, I_C, I_CTX, I_CCTX, I_ADAW, I_ADAB, I_N1G, I_N2G, I_WIN, I_WINQN, I_WINKN, I_SINK, I_DIFQN, I_DIFKN, I_DIFLAM, I_SUBLN,
       I_NATQN, I_NATKN, I_RPB, I_MQAN, I_WQB, I_MKVAN, I_WKVB, I_MQN, I_MKN, I_WBR, I_WOUT, I_RW, I_RB, I_W1, I_W3, I_W2 };

constexpr size_t SZ512 = (size_t)NROW * 512 * 2, SZ768 = (size_t)NROW * 768 * 2, SZ128 = (size_t)NROW * 128 * 2;
constexpr size_t OFF_WQ = 0;
constexpr size_t OFF_DQ = OFF_WQ + SZ512;
constexpr size_t OFF_NQ = OFF_DQ + SZ512;
constexpr size_t OFF_YD = OFF_NQ + SZ512;
constexpr size_t OFF_MQ = OFF_YD + SZ512;
constexpr size_t OFF_QEND = OFF_MQ + SZ768;
constexpr size_t OFF_WK = OFF_QEND;
constexpr size_t OFF_WV = OFF_WK + SZ128;
constexpr size_t OFF_DK = OFF_WV + SZ128;
constexpr size_t OFF_DV = OFF_DK + SZ512;
constexpr size_t OFF_NK = OFF_DV + SZ512;
constexpr size_t OFF_NV = OFF_NK + SZ512;
constexpr size_t OFF_MK = OFF_NV + SZ512;
constexpr size_t OFF_MV = OFF_MK + SZ768;
constexpr size_t OFF_KVEND = OFF_MV + SZ512;
constexpr int TMPLD = 416;
constexpr size_t OFF_TMP = OFF_KVEND;
constexpr size_t OFF_H = OFF_TMP + (size_t)NROW * TMPLD * 2;
constexpr size_t OFF_WT = OFF_H + (size_t)NROW * 1024 * 2;
constexpr size_t WT_WIN = 0;
constexpr size_t WT_WB = WT_WIN + (size_t)8448 * 1024 * 2;
constexpr size_t WT_WO = WT_WB + (size_t)4 * 1024 * 512 * 2;
constexpr size_t WT_WQB = WT_WO + (size_t)1024 * 1024 * 2;
constexpr size_t WT_WKVB = WT_WQB + (size_t)768 * 256 * 2;
constexpr size_t WT_LAYER = WT_WKVB + (size_t)1024 * 128 * 2;
constexpr size_t OFF_SMALL = OFF_WT + 2 * WT_LAYER;
constexpr size_t OFF_MODS = OFF_SMALL;
constexpr size_t OFF_TAB64 = OFF_MODS + (size_t)2 * 3 * 6144 * 4;
constexpr size_t OFF_TAB32 = OFF_TAB64 + 128 * 16 * 8;
constexpr size_t OFF_CONST = OFF_TAB32 + 128 * 8 * 8;
constexpr size_t OFF_CNT = OFF_CONST + 2 * 32 * 4;
constexpr size_t OFF_LIST = OFF_CNT + 256;
constexpr size_t OFF_TOKW = OFF_LIST + (size_t)16 * LCAP * 4;
constexpr size_t OFF_XC = OFF_TOKW + (size_t)NASSIGN * 4;
constexpr size_t OFF_BAR = OFF_XC + (size_t)512 * 1024 * 4;
constexpr size_t OFF_RWT = OFF_BAR + 16384;
constexpr size_t OFF_YS2 = OFF_RWT + 65536;
constexpr DEVI size_t ys_off(int n) { return n < 2 ? OFF_H + (size_t)n * SZ512 : OFF_YS2 + (size_t)(n - 2) * SZ512; }
constexpr int G1_SPLIT = 5888;
constexpr size_t OFF_GB = OFF_YS2 + 2 * SZ512;
constexpr size_t WS_END = OFF_GB + (size_t)(NLAT - G1_SPLIT) * 4096;
constexpr size_t OFF_YBUF = OFF_WQ;
constexpr size_t OFF_M = OFF_WK;
constexpr size_t OFF_MOEW13 = OFF_M + (size_t)NROW * 1024 * 2;
constexpr size_t OFF_MOEW2 = OFF_MOEW13 + (size_t)16 * 1024 * 1024 * 2;
constexpr size_t OFF_HEXP = OFF_MOEW2 + (size_t)16 * 1024 * 512 * 2;
static_assert(OFF_HEXP + (size_t)(NASSIGN + 256) * 512 * 2 <= OFF_KVEND, "KV-area aliases overflow");
static_assert(OFF_YBUF + (size_t)NASSIGN * 1024 * 2 <= OFF_QEND, "Q-area alias overflow");

constexpr int AQB = 1;
constexpr int NW = 8, NTHR = 64 * NW;
constexpr int BM = 256;
constexpr int LDS_BYTES = 147456 + 256;
constexpr int LDS_TIDTAB = LDS_BYTES - 16 - 256;

struct Params { const float* in[32]; float* out; char* ws; };
typedef const __attribute__((address_space(4))) Params& CPR;
typedef const __attribute__((address_space(4))) Params* KPTR;

#define LAS __attribute__((address_space(3)))
DEVI unsigned hw_slot() { return (unsigned)__builtin_amdgcn_s_getreg((5 << 11) | 4) & 63u; }
DEVI void tid_init() { if ((threadIdx.x & 63) == 0) *(volatile LAS int*)(LDS_TIDTAB + hw_slot() * 4) = (int)(threadIdx.x >> 6); __syncthreads(); }
DEVI int lane_opaque() { int t; asm volatile("v_mbcnt_lo_u32_b32 %0, -1, 0\n\tv_mbcnt_hi_u32_b32 %0, -1, %0" : "=&v"(t)); return t; }
DEVI float shx(float v, int m) { return __int_as_float(__builtin_amdgcn_ds_bpermute((lane_opaque() ^ m) << 2, __float_as_int(v))); }
DEVI float shl_(float v, int src) { return __int_as_float(__builtin_amdgcn_ds_bpermute(src << 2, __float_as_int(v))); }
DEVI float rflf(float x) { return __int_as_float(__builtin_amdgcn_readfirstlane(__float_as_int(x))); }
DEVI int TID() {
  const int w = __builtin_amdgcn_readfirstlane(*(volatile LAS int*)(LDS_TIDTAB + hw_slot() * 4));
  return w * 64 + lane_opaque();
}
DEVI float bf2f(u16 v) { return __uint_as_float(((unsigned)v) << 16); }
DEVI float lo_f(unsigned w) { return __uint_as_float(w << 16); }
DEVI float hi_f(unsigned w) { return __uint_as_float(w & 0xffff0000u); }
typedef __bf16 bf16v2_t __attribute__((ext_vector_type(2)));
typedef float f32v2_t __attribute__((ext_vector_type(2)));
DEVI unsigned pk2(float lo, float hi) { f32v2_t v = {lo, hi}; bf16v2_t b = __builtin_convertvector(v, bf16v2_t); return __builtin_bit_cast(unsigned, b); }
DEVI void st4(u16* p, float a, float b, float c, float d) { uint2 v; v.x = pk2(a, b); v.y = pk2(c, d); *(uint2*)p = v; }
DEVI float fexp2(float x) { return __builtin_amdgcn_exp2f(x); }
DEVI float sigmoidf_(float x) { return __builtin_amdgcn_rcpf(1.f + __builtin_amdgcn_exp2f(-x * LOG2E)); }
DEVI float wave_sum(float v) {
#pragma unroll
  for (int o = 1; o < 64; o <<= 1) v += shx(v, o);
  return v;
}

DEVI void glds16(const void* gsrc, char* lds_wave_base) { __builtin_amdgcn_global_load_lds((const unsigned*)gsrc, (unsigned*)lds_wave_base, 16, 0, 0); }
template <int BN, int WMW, int WNW, int NST = 2, class ARowF>
DEVI void gemm_tile(f32x4 (&acc)[BN / WNW / 16][BM / WMW / 16], ARowF arow, const u16* __restrict__ Wt, int ldw, int K, char* lds, int tid) {
  static_assert(WMW * WNW == NW, "eight waves");
  static_assert(NST == 2 || (BN % 64 == 0 && 3 * (BM * 128 + BN * 128) <= 131072), "ring: uniform loads per lane, slots below 128 KiB");
  constexpr int MI = BM / WMW / 16, NI = BN / WNW / 16, WMT = BM / WMW, WNT = BN / WNW, XB = BM * 128, BUFB = XB + BN * 128;
  constexpr int WPASS = (BN + 63) / 64;
  const int lane = tid & 63, wave = __builtin_amdgcn_readfirstlane(tid >> 6), wm = wave / WNW, wn = wave % WNW;
  const int srow = wave * 8 + (lane >> 3);
  const int schunk = (lane & 7) ^ ((srow >> 1) & 7);
  const u16* xp[BM / 64];
#pragma unroll
  for (int p = 0; p < BM / 64; ++p) xp[p] = arow(srow + 64 * p) + schunk * 8;
  const u16* wp = Wt + (size_t)srow * ldw + schunk * 8;
  auto issue = [&](int k0, int b) {
    char* Xs = lds + b * BUFB + wave * 1024; char* Ws = Xs + XB;
#pragma unroll
    for (int p = 0; p < BM / 64; ++p) glds16(xp[p] + k0, Xs + p * 8192);
#pragma unroll
    for (int p = 0; p < WPASS; ++p) if (p * 64 + wave * 8 < BN) glds16(wp + (size_t)(64 * p) * ldw + k0, Ws + p * 8192);
  };
  const int fsw = (lane >> 1) & 7, fq = lane >> 4;
  const int foff0 = (lane & 15) * 128 + ((fq ^ fsw) << 4), foff1 = (lane & 15) * 128 + (((4 + fq) ^ fsw) << 4);
  issue(0, 0);
  if (NST == 3) { if (K > 64) issue(64, 1); }
  else { asm volatile("s_waitcnt vmcnt(0)" ::: "memory"); __syncthreads(); }
  int b = 0;
  for (int k0 = 0; k0 < K; k0 += 64) {
    if (NST == 3) {
      if (k0 + 64 < K) asm volatile("s_waitcnt vmcnt(%0)" :: "n"(BM / 64 + WPASS) : "memory"); else asm volatile("s_waitcnt vmcnt(0)" ::: "memory");
      __syncthreads();
      if (k0 + 128 < K) issue(k0 + 128, b >= 1 ? b - 1 : 2);
    } else if (k0 + 64 < K) issue(k0 + 64, b ^ 1);
    const char* Xs = lds + b * BUFB; const char* Ws = Xs + XB;
#pragma unroll
    for (int kk = 0; kk < 2; ++kk) {
      const int fo = kk ? foff1 : foff0;
      bf16x8 wf[NI], xf[MI];
#pragma unroll
      for (int ni = 0; ni < NI; ++ni) wf[ni] = *(const bf16x8*)(Ws + (wn * WNT + ni * 16) * 128 + fo);
#pragma unroll
      for (int mi = 0; mi < MI; ++mi) xf[mi] = *(const bf16x8*)(Xs + (wm * WMT + mi * 16) * 128 + fo);
#pragma unroll
      for (int ni = 0; ni < NI; ++ni)
#pragma unroll
        for (int mi = 0; mi < MI; ++mi) acc[ni][mi] = __builtin_amdgcn_mfma_f32_16x16x32_bf16(wf[ni], xf[mi], acc[ni][mi], 0, 0, 0);
    }
    if (NST == 3) { b = b == 2 ? 0 : b + 1; }
    else { asm volatile("s_waitcnt vmcnt(0)" ::: "memory"); __syncthreads(); b ^= 1; }
  }
  if (NST == 3) __syncthreads();
}

DEVI int g8_lds_byte(int r, int c) { const int st = (r >> 4) * 2 + (c >> 5), rr = r & 15, cc = c & 31, ob = rr * 64 + cc * 2; return st * 1024 + (ob ^ (((ob >> 9) & 1) << 5)); }
DEVI void g8_stage_rc(int b, int& R, int& C) { const int st = b >> 10, sb = b & 1023, swz = sb ^ (((sb >> 9) & 1) << 5); R = (st >> 1) * 16 + (swz >> 6); C = (st & 1) * 32 + ((swz & 63) >> 1); }
template <bool GATHER, int MODE, class XOffF>
DEVI void gemm256(f32x4 (&acc)[2][2][4][2], const u16* __restrict__ W, int ldw, const u16* __restrict__ X, XOffF xrowoff, int K, char* lds, int tid) {
  constexpr int HT = 128 * 64 * 2;
  const int wid = __builtin_amdgcn_readfirstlane(tid >> 6), lane = tid & 63, wr = wid >> 2, wc = wid & 3, fr = lane & 15, fq = lane >> 4;
  unsigned woff[2], xoff[2], xoff1[GATHER ? 2 : 1];
#pragma unroll
  for (int i = 0; i < 2; ++i) { int r_, c_; g8_stage_rc(tid * 16 + i * 8192, r_, c_); woff[i] = (unsigned)(r_ * ldw + c_) * 2u; xoff[i] = (unsigned)(xrowoff(r_) + c_) * 2u; if (GATHER) xoff1[i] = (unsigned)(xrowoff(128 + r_) + c_) * 2u; }
  const char* W1 = (const char*)(W + (size_t)128 * ldw); const char* X1 = (const char*)(GATHER ? X : X + (size_t)xrowoff(128));
  const char* W0 = (const char*)W; const char* X0 = (const char*)X;
#define G8_STAGE_X1(P, kt) do { const char* _b = X1 + (size_t)((kt) * 128); asm volatile("" : "+s"(_b)); _Pragma("unroll") for (int _i = 0; _i < 2; ++_i) glds16(_b + (size_t)(GATHER ? xoff1[GATHER ? _i : 0] : xoff[_i]), (P) + wid * 1024 + _i * 8192); } while (0)
#define G8_SA(b, h) (lds + ((b) * 2 + (h)) * HT)
#define G8_SB(b, h) (lds + (4 + (b) * 2 + (h)) * HT)
#define G8_STAGE(P, base, off, kt) do { const char* _b = (base) + (size_t)((kt) * 128); asm volatile("" : "+s"(_b)); _Pragma("unroll") for (int _i = 0; _i < 2; ++_i) glds16(_b + (size_t)off[_i], (P) + wid * 1024 + _i * 8192); } while (0)
#define G8_LDA(dst, b, h) do { _Pragma("unroll") for (int m = 0; m < 4; ++m) _Pragma("unroll") for (int k = 0; k < 2; ++k) dst[m][k] = *(const bf16x8*)(G8_SA(b, h) + ldsA + (m * 2048 + k * 1024)); } while (0)
#define G8_LDB(dst, b, h) do { _Pragma("unroll") for (int n = 0; n < 2; ++n) _Pragma("unroll") for (int k = 0; k < 2; ++k) dst[n][k] = *(const bf16x8*)(G8_SB(b, h) + ldsB + (n * 2048 + k * 1024)); } while (0)
#define G8_MMA(ai, bj, At, Bt) do { __builtin_amdgcn_s_setprio(1); _Pragma("unroll") for (int m = 0; m < 4; ++m) _Pragma("unroll") for (int n = 0; n < 2; ++n) _Pragma("unroll") for (int k = 0; k < 2; ++k) \
    acc[ai][bj][m][n] = __builtin_amdgcn_mfma_f32_16x16x32_bf16(At[m][k], Bt[n][k], acc[ai][bj][m][n], 0, 0, 0); __builtin_amdgcn_s_setprio(0); } while (0)
#define G8_WV(n) asm volatile("s_waitcnt vmcnt(" #n ")" ::: "memory")
#define G8_WL(n) asm volatile("s_waitcnt lgkmcnt(" #n ")" ::: "memory")
#define G8_BAR __builtin_amdgcn_s_barrier()
#define G8_SCHED __builtin_amdgcn_sched_barrier(0)
  bf16x8 At[4][2], B0[2][2], B1[2][2];
  int ldsA = g8_lds_byte(wr * 64 + fr, fq * 8), ldsB = g8_lds_byte(wc * 32 + fr, fq * 8);
  asm volatile("" : "+v"(ldsA), "+v"(ldsB));
  const int nt = K >> 6;
  if (MODE != 2) {
    G8_STAGE(G8_SB(0, 0), X0, xoff, 0); G8_STAGE(G8_SA(0, 0), W0, woff, 0);
    G8_STAGE_X1(G8_SB(0, 1), 0); G8_STAGE(G8_SA(0, 1), W1, woff, 0);
    G8_STAGE(G8_SB(1, 0), X0, xoff, 1); G8_STAGE(G8_SA(1, 0), W0, woff, 1); G8_STAGE_X1(G8_SB(1, 1), 1);
  }
  if (MODE == 1) return;
  if (wr == 1) G8_BAR;
  if (MODE == 2) { G8_WV(0); G8_BAR; G8_BAR; }
  else { G8_WV(10); G8_BAR; G8_WV(6); G8_BAR; }
#pragma unroll 1
  for (int t = 0; t < nt - 2; t += 2) {
    G8_LDB(B0, 0, 0); G8_SCHED; G8_LDA(At, 0, 0); G8_STAGE(G8_SA(1, 1), W1, woff, t + 1);
    G8_WL(8); G8_BAR; G8_WL(0); G8_MMA(0, 0, At, B0); G8_BAR; G8_SCHED;
    G8_LDB(B1, 0, 1); G8_STAGE(G8_SB(0, 0), X0, xoff, t + 2);
    G8_BAR; G8_WL(0); G8_MMA(0, 1, At, B1); G8_BAR;
    G8_LDA(At, 0, 1); G8_STAGE(G8_SA(0, 0), W0, woff, t + 2);
    G8_BAR; G8_WL(0); G8_MMA(1, 0, At, B0); G8_BAR; G8_SCHED;
    G8_STAGE_X1(G8_SB(0, 1), t + 2);
    G8_WV(6); G8_BAR; G8_MMA(1, 1, At, B1); G8_BAR;
    G8_LDB(B0, 1, 0); G8_SCHED; G8_LDA(At, 1, 0); G8_STAGE(G8_SA(0, 1), W1, woff, t + 2);
    G8_WL(8); G8_BAR; G8_WL(0); G8_MMA(0, 0, At, B0); G8_BAR; G8_SCHED;
    G8_LDB(B1, 1, 1); G8_STAGE(G8_SB(1, 0), X0, xoff, t + 3);
    G8_BAR; G8_WL(0); G8_MMA(0, 1, At, B1); G8_BAR;
    G8_LDA(At, 1, 1); G8_STAGE(G8_SA(1, 0), W0, woff, t + 3);
    G8_BAR; G8_WL(0); G8_MMA(1, 0, At, B0); G8_BAR; G8_SCHED;
    G8_STAGE_X1(G8_SB(1, 1), t + 3);
    G8_WV(6); G8_BAR; G8_MMA(1, 1, At, B1); G8_BAR;
  }
  { G8_LDB(B0, 0, 0); G8_LDA(At, 0, 0); G8_STAGE(G8_SA(1, 1), W1, woff, nt - 1);
    G8_BAR; G8_WL(0); G8_MMA(0, 0, At, B0); G8_BAR;
    G8_LDB(B1, 0, 1); G8_BAR; G8_WL(0); G8_MMA(0, 1, At, B1); G8_BAR;
    G8_LDA(At, 0, 1); G8_WV(4); G8_BAR; G8_WL(0); G8_MMA(1, 0, At, B0); G8_MMA(1, 1, At, B1); G8_BAR; }
  { G8_LDB(B0, 1, 0); G8_LDA(At, 1, 0); G8_WV(2); G8_BAR; G8_WL(0); G8_MMA(0, 0, At, B0); G8_BAR;
    G8_LDB(B1, 1, 1); G8_WV(0); G8_BAR; G8_WL(0); G8_MMA(0, 1, At, B1); G8_BAR;
    G8_LDA(At, 1, 1); G8_BAR; G8_WL(0); G8_MMA(1, 0, At, B0); G8_MMA(1, 1, At, B1); G8_BAR; }
  if (wr == 0) G8_BAR;
  __syncthreads();
}

struct ConvD { const float* src; const float* ksc; u16* dst; int K, N, mode; };
DEVI int conv_dstrow(int mode, int n) {
  if (mode == 1) return n < 4256 ? n : n + 96;
  if (mode == 2) return (n >> 5) * 64 + (n & 31);
  if (mode == 3) return (n >> 5) * 64 + 32 + (n & 31);
  return n;
}
DEVI void tr_item64(const float* __restrict__ src, int N, int K, int k0, int n0, const float* __restrict__ ksc, u16* __restrict__ dst, int mode, float* scr, int lane) {
  const int c = lane & 15, rr = lane >> 4;
  const bool colok = n0 + 4 * c < N;
  float4 v[16];
#pragma unroll
  for (int i = 0; i < 16; ++i) { const int k = 4 * i + rr; v[i] = colok ? *(const float4*)(src + (size_t)(k0 + k) * N + n0 + 4 * c) : make_float4(0.f, 0.f, 0.f, 0.f); }
#pragma unroll
  for (int i = 0; i < 16; ++i) { const int k = 4 * i + rr; float4 x = v[i];
    if (ksc) { const float f = ksc[k0 + k]; x.x *= f; x.y *= f; x.z *= f; x.w *= f; }
    *(float4*)(scr + k * 68 + 4 * c) = x; }
  asm volatile("s_waitcnt lgkmcnt(0)" ::: "memory");
  const int n = n0 + lane;
  if (n < N) {
    u16* drow = dst + (size_t)conv_dstrow(mode, n) * K + k0;
#pragma unroll
    for (int cc = 0; cc < 8; ++cc) { const float* sp = scr + (8 * cc) * 68 + lane;
      uint4 o; o.x = pk2(sp[0], sp[68]); o.y = pk2(sp[136], sp[204]); o.z = pk2(sp[272], sp[340]); o.w = pk2(sp[408], sp[476]);
      *(uint4*)(drow + 8 * cc) = o; }
  }
  asm volatile("s_waitcnt lgkmcnt(0)" ::: "memory");
}
DEVI int conv_nitems(int K, int N) { return (K >> 6) * ((N + 63) >> 6); }
DEVI ConvD p0_desc(CPR p, int d) {
  const int l = d >> 3, j = d & 7; ConvD c; c.ksc = nullptr; c.mode = 0;
  char* wt = p.ws + OFF_WT + (size_t)l * WT_LAYER;
  if (j == 0) { c.src = p.in[I_WIN] + (size_t)l * 1024 * DIN; c.K = 1024; c.N = DIN; c.dst = (u16*)(wt + WT_WIN); c.mode = 1; }
  else if (j <= 4) { int n = j - 1; c.src = p.in[I_WBR] + (size_t)(l * 4 + n) * 512 * 1024; c.K = 512; c.N = 1024; c.dst = (u16*)(wt + WT_WB) + (size_t)n * 1024 * 512; }
  else if (j == 5) { c.src = p.in[I_WOUT] + (size_t)l * 1024 * 1024; c.K = 1024; c.N = 1024; c.dst = (u16*)(wt + WT_WO); }
  else if (j == 6) { c.src = p.in[I_WQB] + (size_t)l * 256 * 768; c.K = 256; c.N = 768; c.dst = (u16*)(wt + WT_WQB); c.ksc = p.in[I_MQAN] + l * 256; }
  else { c.src = p.in[I_WKVB] + (size_t)l * 128 * 1024; c.K = 128; c.N = 1024; c.dst = (u16*)(wt + WT_WKVB); c.ksc = p.in[I_MKVAN] + l * 128; }
  return c;
}
DEVI ConvD moe_desc(CPR p, int l, int d) {
  const int e = d / 3, w = d % 3; ConvD c; c.ksc = nullptr;
  if (w < 2) { c.src = p.in[w == 0 ? I_W1 : I_W3] + (size_t)(l * 16 + e) * 1024 * 512; c.K = 1024; c.N = 512; c.dst = (u16*)(p.ws + OFF_MOEW13) + (size_t)e * 1024 * 1024; c.mode = 2 + w; }
  else { c.src = p.in[I_W2] + (size_t)(l * 16 + e) * 512 * 1024; c.K = 512; c.N = 1024; c.dst = (u16*)(p.ws + OFF_MOEW2) + (size_t)e * 1024 * 512; c.mode = 0; }
  return c;
}
template <class DescF>
DEVI void conv_run_w(int ndesc, int total, DescF descf, char* scr_base, int wave0, int nwv) {
  const int tid = TID(), lane = tid & 63, wave = tid >> 6;
  if (wave < wave0 || wave >= wave0 + nwv) return;
  float* scr = (float*)scr_base + (wave - wave0) * (64 * 68);
  for (int item = blockIdx.x * nwv + (wave - wave0); item < total; item += gridDim.x * nwv) {
    ConvD c; c.src = nullptr; c.ksc = nullptr; c.dst = nullptr; c.K = 64; c.N = 64; c.mode = 0;
    int rem = item;
    for (int d = 0; d < ndesc; ++d) {
      ConvD t = descf(d); const int n = conv_nitems(t.K, t.N);
      if (rem < n) { c = t; break; }
      rem -= n;
    }
    const int nbn = (c.N + 63) >> 6; const int k0 = (rem / nbn) * 64, n0 = (rem % nbn) * 64;
    tr_item64(c.src, c.N, c.K, k0, n0, c.ksc, c.dst, c.mode, scr, lane);
  }
}
template <class DescF>
DEVI void conv_run(int ndesc, int total, DescF descf, char* lds) { conv_run_w(ndesc, total, descf, lds, 0, NW); __syncthreads(); }
template <class DescF>
DEVI void conv_run_part(int d0, int ndesc, DescF descf, char* lds, int vb, int nvb) {
  const int tid = TID(), lane = tid & 63, wave = tid >> 6;
  float* scr = (float*)lds + wave * (64 * 68);
  int total = 0;
  for (int d = 0; d < ndesc; ++d) { ConvD t = descf(d0 + d); total += conv_nitems(t.K, t.N); }
  for (int item = vb * NW + wave; item < total; item += nvb * NW) {
    ConvD c; c.src = nullptr; c.ksc = nullptr; c.dst = nullptr; c.K = 64; c.N = 64; c.mode = 0;
    int rem = item;
    for (int d = 0; d < ndesc; ++d) { ConvD t = descf(d0 + d); const int n = conv_nitems(t.K, t.N); if (rem < n) { c = t; break; } rem -= n; }
    const int nbn = (c.N + 63) >> 6; const int k0 = (rem / nbn) * 64, n0 = (rem % nbn) * 64;
    tr_item64(c.src, c.N, c.K, k0, n0, c.ksc, c.dst, c.mode, scr, lane);
  }
  __syncthreads();
}

DEVI void phase0(CPR p, char* lds) {
  const int tid = TID();
  {
    float* s = (float*)lds; float* red = s + 3072;
    float* mods = (float*)(p.ws + OFF_MODS);
    for (int it = blockIdx.x; it < 384; it += gridDim.x) {
      const int l = it / 192, j0 = (it % 192) * 32;
      for (int i = tid; i < 3072; i += NTHR) { int r = i >> 10, k = i & 1023; float cv = r < 2 ? p.in[I_C][r * 1024 + k] : p.in[I_CCTX][k]; s[i] = cv / (1.f + __expf(-cv)); }
      __syncthreads();
      const int j = tid & 31, kq = tid >> 5;
      const float* W = p.in[I_ADAW] + (size_t)l * 1024 * 6144 + j0 + j;
      float a0 = 0, a1 = 0, a2 = 0;
#pragma unroll 16
      for (int k = kq * 64; k < kq * 64 + 64; ++k) { float w = W[(size_t)k * 6144]; a0 += s[k] * w; a1 += s[1024 + k] * w; a2 += s[2048 + k] * w; }
      red[(kq * 3 + 0) * 32 + j] = a0; red[(kq * 3 + 1) * 32 + j] = a1; red[(kq * 3 + 2) * 32 + j] = a2;
      __syncthreads();
      if (tid < 96) { int r = tid >> 5, jj = tid & 31; float v = p.in[I_ADAB][l * 6144 + j0 + jj];
        for (int q = 0; q < 16; ++q) v += red[(q * 3 + r) * 32 + jj];
        mods[(size_t)(l * 3 + r) * 6144 + j0 + jj] = v; }
      __syncthreads();
    }
  }
  {
    float2* t64 = (float2*)(p.ws + OFF_TAB64); float2* t32 = (float2*)(p.ws + OFF_TAB32);
    const int gb = (int)gridDim.x - 1 - (int)blockIdx.x;
    if (gb >= 1 && gb <= 4) { const int i = (gb - 1) * NTHR + tid; const int pos = i >> 4, j = i & 15; float f = expf(-logf(10000.f) * (float)j / 16.f); float ang = (float)pos * f; t64[i] = make_float2((float)cos((double)ang), (float)sin((double)ang)); }
    if (gb >= 5 && gb <= 6) { const int i = (gb - 5) * NTHR + tid; const int pos = i >> 3, j = i & 7; float f = expf(-logf(10000.f) * (float)j / 8.f); float ang = (float)pos * f; t32[i] = make_float2((float)cos((double)ang), (float)sin((double)ang)); }
    if (gb >= 7 && gb < 7 + 32) { const int i = (gb - 7) * NTHR + tid; const int e = i >> 10, k = i & 1023; ((float*)(p.ws + OFF_RWT))[i] = p.in[I_RW][k * 16 + e]; }
  }
  if (blockIdx.x == gridDim.x - 1) {
    if (tid < 32) ((int*)(p.ws + OFF_CNT))[tid] = 0;
    const int lane = tid & 63, wave = tid >> 6;
    auto wmax = [&](float v) {
#pragma unroll
      for (int o = 1; o < 64; o <<= 1) v = fmaxf(v, shx(v, o));
      return v; };
    auto amax = [&](const float* a, int n) { float m = 0.f; for (int i = lane; i < n; i += 64) m = fmaxf(m, fabsf(a[i])); return wmax(m); };
    if (wave < 2) {
      const int l = wave; float* cst = (float*)(p.ws + OFF_CONST) + l * 32;
      const float* lm = p.in[I_DIFLAM] + l * 256;
      const float s01 = wave_sum(lm[lane] * lm[64 + lane]), s23 = wave_sum(lm[128 + lane] * lm[192 + lane]);
      const float lam_init = 0.8f - 0.6f * expf(-0.3f * (float)l);
      const float c2 = 8.f * amax(p.in[I_WINQN] + l * 64, 64) * amax(p.in[I_WINKN] + l * 64, 64);
      const float c3 = 8.f * amax(p.in[I_DIFQN] + l * 64, 64) * amax(p.in[I_DIFKN] + l * 64, 64);
      const float c4 = 8.f * amax(p.in[I_NATQN] + l * 64, 64) * amax(p.in[I_NATKN] + l * 64, 64);
      const float c5 = sqrtf(96.f) * amax(p.in[I_MQN] + l * 96, 96) * amax(p.in[I_MKN] + l * 96, 96);
      if (lane == 0) { cst[0] = expf(s01) - expf(s23) + lam_init; cst[1] = lam_init; cst[2] = c2; cst[3] = c3; cst[4] = c4; cst[5] = c5; }
    }
    for (int q = wave; q < 16; q += NW) {
      const int l = q >> 3, h = q & 7; const float m = amax(p.in[I_RPB] + (size_t)(l * 8 + h) * 465, 465);
      if (lane == 0) ((float*)(p.ws + OFF_CONST))[l * 32 + 8 + h] = m;
    }
  }
}

DEVI void moe_combine(CPR p, int row, int lane, float4 (&v)[4], const float* g2) {
  const u16* yb = (const u16*)(p.ws + OFF_YBUF); const float* tw = (const float*)(p.ws + OFF_TOKW);
  const float w0 = tw[row * 2], w1 = tw[row * 2 + 1];
#pragma unroll
  for (int j = 0; j < 4; ++j) {
    const int k = lane * 4 + 256 * j;
    uint2 a = *(const uint2*)(yb + (size_t)(row * 2) * 1024 + k), b = *(const uint2*)(yb + (size_t)(row * 2 + 1) * 1024 + k);
    float4 g = *(const float4*)(g2 + k);
    v[j].x += g.x * (w0 * lo_f(a.x) + w1 * lo_f(b.x)); v[j].y += g.y * (w0 * hi_f(a.x) + w1 * hi_f(b.x));
    v[j].z += g.z * (w0 * lo_f(a.y) + w1 * lo_f(b.y)); v[j].w += g.w * (w0 * hi_f(a.y) + w1 * hi_f(b.y));
  }
}
DEVI void phase1(CPR p, int l, char* lds) {
  const int tid = TID(), lane = tid & 63, wave = tid >> 6;
  const float* mods = (const float*)(p.ws + OFF_MODS);
  u16* H = (u16*)(p.ws + OFF_H);
  for (int row = blockIdx.x * NW + wave; row < NROW; row += gridDim.x * NW) {
    const bool lat = row < NLAT; const int ridx = lat ? (row >> 13) : 2;
    const float* src;
    if (l == 0) src = lat ? p.in[I_X] + (size_t)row * 1024 : p.in[I_CTX] + (size_t)(row - NLAT) * 1024;
    else src = lat ? p.out + (size_t)row * 1024 : (const float*)(p.ws + OFF_XC) + (size_t)(row - NLAT) * 1024;
    float4 v[4];
#pragma unroll
    for (int j = 0; j < 4; ++j) v[j] = *(const float4*)(src + lane * 4 + 256 * j);
    if (l == 1) {
      moe_combine(p, row, lane, v, mods + (size_t)(0 * 3 + ridx) * 6144 + 5120);
      if (lat) {
#pragma unroll
        for (int j = 0; j < 4; ++j) *(float4*)(p.out + (size_t)row * 1024 + lane * 4 + 256 * j) = v[j];
      }
    }
    float ss = 0;
#pragma unroll
    for (int j = 0; j < 4; ++j) ss += v[j].x * v[j].x + v[j].y * v[j].y + v[j].z * v[j].z + v[j].w * v[j].w;
    ss = wave_sum(ss);
    const float rs = rsqrtf(ss * (1.f / 1024.f) + EPS);
    const float* md = mods + (size_t)(l * 3 + ridx) * 6144; const float* ng = p.in[I_N1G] + l * 1024;
#pragma unroll
    for (int j = 0; j < 4; ++j) {
      const int k = lane * 4 + 256 * j;
      float4 g = *(const float4*)(ng + k), sh = *(const float4*)(md + k), sc = *(const float4*)(md + 1024 + k);
      st4(H + (size_t)row * 1024 + k, v[j].x * rs * g.x * (1.f + sc.x) + sh.x, v[j].y * rs * g.y * (1.f + sc.y) + sh.y,
          v[j].z * rs * g.z * (1.f + sc.z) + sh.z, v[j].w * rs * g.w * (1.f + sc.w) + sh.w);
    }
  }
  if (l == 0) {
    int total = 0;
    for (int d = 0; d < 16; ++d) { ConvD t = p0_desc(p, d); total += conv_nitems(t.K, t.N); }
    conv_run(16, total, [&](int d) { return p0_desc(p, d); }, lds);
  }
}
DEVI void phase_final(CPR p) {
  const int tid = TID(), lane = tid & 63, wave = tid >> 6;
  const float* mods = (const float*)(p.ws + OFF_MODS);
  for (int row = blockIdx.x * NW + wave; row < NLAT; row += gridDim.x * NW) {
    float4 v[4];
#pragma unroll
    for (int j = 0; j < 4; ++j) v[j] = *(const float4*)(p.out + (size_t)row * 1024 + lane * 4 + 256 * j);
    moe_combine(p, row, lane, v, mods + (size_t)(1 * 3 + (row >> 13)) * 6144 + 5120);
#pragma unroll
    for (int j = 0; j < 4; ++j) *(float4*)(p.out + (size_t)row * 1024 + lane * 4 + 256 * j) = v[j];
  }
}

DEVI bool xcd_tile(int idx, int nM, int nN, int& mt, int& nt) {
  const int x = idx & 7, y = idx >> 3;
  const int Mx = (nM - x + 7) >> 3;
  if (y >= Mx * nN) return false;
  const int mg = y / (8 * nN);
  const int mh = (Mx - 8 * mg) < 8 ? (Mx - 8 * mg) : 8;
  int rem = y - mg * 8 * nN;
  const int ng = rem / (mh * 8);
  rem -= ng * mh * 8;
  mt = x + 8 * (8 * mg + rem % mh); nt = ng * 8 + rem / mh;
  return true;
}
DEVI int xcd_slots(int nM, int nN) { return 8 * ((nM + 7) >> 3) * nN; }

DEVI unsigned* hand_ctr(CPR p, int l, int k) { return (unsigned*)(p.ws + OFF_BAR) + 3456 + l * 8 + k; }
DEVI void st4_wt(u16* p, float a, float b, float c, float d) {
  __hip_atomic_store((unsigned long long*)p, (unsigned long long)pk2(a, b) | ((unsigned long long)pk2(c, d) << 32), __ATOMIC_RELAXED, __HIP_MEMORY_SCOPE_SYSTEM); }
DEVI void publish_drained(unsigned* ctr, int tid) {
  asm volatile("s_waitcnt vmcnt(0)" ::: "memory");
  __syncthreads();
  if (tid == 0) (void)__hip_atomic_fetch_add(ctr, 1u, __ATOMIC_RELAXED, __HIP_MEMORY_SCOPE_AGENT);
}
DEVI void wait_ctr(unsigned* ctr, unsigned target, unsigned* tmo, int tid) {
  if (tid == 0) { unsigned sp = 0;
    while (__hip_atomic_load(ctr, __ATOMIC_RELAXED, __HIP_MEMORY_SCOPE_AGENT) < target) { __builtin_amdgcn_s_sleep(2);
      if ((++sp & 255u) == 0u) { if (__hip_atomic_load(tmo, __ATOMIC_RELAXED, __HIP_MEMORY_SCOPE_AGENT)) break; if (sp > (1u << 20)) { atomicAdd(tmo, 1u); break; } } }
    __builtin_amdgcn_fence(__ATOMIC_ACQUIRE, "agent"); }
  __syncthreads();
}
static_assert((size_t)G1_SPLIT * 4096 <= WT_LAYER && NROW - NLAT <= NLAT - G1_SPLIT, "gate buffers");
DEVI unsigned char* gate_row(CPR p, int l, int row) {
  if (l == 0) return row < NLAT ? (unsigned char*)p.out + (size_t)row * 4096 : (unsigned char*)(p.ws + OFF_GB) + (size_t)(row - NLAT) * 4096;
  return row < G1_SPLIT ? (unsigned char*)(p.ws + OFF_WT) + (size_t)row * 4096 : (unsigned char*)(p.ws + OFF_GB) + (size_t)(row - G1_SPLIT) * 4096;
}
DEVI void p2_item(CPR p, int l, int mt, int nt2, bool hasNext, int mtN, int ntN, char* lds) {
  const int tid = TID(), lane = tid & 63, wave = __builtin_amdgcn_readfirstlane(tid >> 6), wr = wave >> 2, wc = wave & 3;
  const u16* H = (const u16*)(p.ws + OFF_H) + (size_t)mt * BM * 1024;
  const u16* Wt = (const u16*)(p.ws + OFF_WT + (size_t)l * WT_LAYER + WT_WIN) + (size_t)nt2 * 256 * 1024;
  f32x4 acc[2][2][4][2];
#pragma unroll
  for (int a = 0; a < 2; ++a)
#pragma unroll
    for (int b = 0; b < 2; ++b)
#pragma unroll
      for (int c = 0; c < 4; ++c) { acc[a][b][c][0] = f32x4{0, 0, 0, 0}; acc[a][b][c][1] = f32x4{0, 0, 0, 0}; }
  gemm256<false, 2>(acc, Wt, 1024, H, [&](int r) { return r * 1024; }, 1024, lds, tid);
  if (hasNext) gemm256<false, 1>(acc, (const u16*)(p.ws + OFF_WT + (size_t)l * WT_LAYER + WT_WIN) + (size_t)ntN * 256 * 1024, 1024, (const u16*)(p.ws + OFF_H) + (size_t)mtN * BM * 1024, [&](int r) { return r * 1024; }, 1024, lds, tid);
  const bool lat = mt < NLAT / BM; const int c4 = (lane >> 4) * 4;
  if (nt2 >= 17) {
#pragma unroll
    for (int bj = 0; bj < 2; ++bj)
#pragma unroll
      for (int n = 0; n < 2; ++n) {
        unsigned char* grow = gate_row(p, l, mt * BM + bj * 128 + wc * 32 + n * 16 + (lane & 15)) + (nt2 - 17) * 256 + wr * 64 + c4;
#pragma unroll
        for (int ai = 0; ai < 2; ++ai)
#pragma unroll
          for (int m = 0; m < 4; ++m) { const f32x4 v = acc[ai][bj][m][n];
            const unsigned q0 = (unsigned)(sigmoidf_(v[0]) * 255.f + 0.5f), q1 = (unsigned)(sigmoidf_(v[1]) * 255.f + 0.5f), q2 = (unsigned)(sigmoidf_(v[2]) * 255.f + 0.5f), q3 = (unsigned)(sigmoidf_(v[3]) * 255.f + 0.5f);
            *(unsigned*)(grow + ai * 128 + m * 16) = q0 | (q1 << 8) | (q2 << 16) | (q3 << 24); }
      }
    return;
  }
  const float2* t64 = (const float2*)(p.ws + OFF_TAB64);
#pragma unroll
  for (int ai = 0; ai < 2; ++ai) {
    const int nt = nt2 * 2 + ai;
    size_t doff; int ldd, dcol; const float* nw = nullptr; bool rope = false; int ncols = 128;
    if (nt < 4)       { doff = OFF_WQ; ldd = 512; dcol = nt * 128; nw = p.in[I_WINQN] + l * 64; rope = true; }
    else if (nt == 4) { doff = OFF_WK; ldd = 128; dcol = 0; nw = p.in[I_WINKN] + l * 64; rope = true; }
    else if (nt == 5) { doff = OFF_WV; ldd = 128; dcol = 0; }
    else if (nt < 10) { doff = OFF_DQ; ldd = 512; dcol = (nt - 6) * 128; nw = p.in[I_DIFQN] + l * 64; rope = true; }
    else if (nt < 14) { doff = OFF_DK; ldd = 512; dcol = (nt - 10) * 128; nw = p.in[I_DIFKN] + l * 64; rope = true; }
    else if (nt < 18) { doff = OFF_DV; ldd = 512; dcol = (nt - 14) * 128; }
    else if (nt < 22) { doff = OFF_NQ; ldd = 512; dcol = (nt - 18) * 128; nw = p.in[I_NATQN] + l * 64; }
    else if (nt < 26) { doff = OFF_NK; ldd = 512; dcol = (nt - 22) * 128; nw = p.in[I_NATKN] + l * 64; }
    else if (nt < 30) { doff = OFF_NV; ldd = 512; dcol = (nt - 26) * 128; }
    else if (nt < 32) { doff = OFF_TMP; ldd = TMPLD; dcol = (nt - 30) * 128; }
    else if (nt == 32) { doff = OFF_TMP; ldd = TMPLD; dcol = 256; }
    else { doff = OFF_TMP; ldd = TMPLD; dcol = 384; ncols = 32; }
    u16* dst = (u16*)(p.ws + doff);
    const float qs = (nt < 4 || (nt >= 6 && nt < 10) || (nt >= 18 && nt < 22)) ? 0.125f * LOG2E : 1.f;
#pragma unroll
    for (int bj = 0; bj < 2; ++bj)
#pragma unroll
      for (int n = 0; n < 2; ++n) {
        const int row = mt * BM + bj * 128 + wc * 32 + n * 16 + (lane & 15);
        float v[4][4];
#pragma unroll
        for (int ni = 0; ni < 4; ++ni)
#pragma unroll
          for (int r = 0; r < 4; ++r) v[ni][r] = acc[ai][bj][ni][n][r];
        if (nw) {
          float ss = 0;
#pragma unroll
          for (int ni = 0; ni < 4; ++ni)
#pragma unroll
            for (int r = 0; r < 4; ++r) ss += v[ni][r] * v[ni][r];
          ss += shx(ss, 16); ss += shx(ss, 32);
          const float rs = rsqrtf(ss * (1.f / 64.f) + EPS) * qs;
#pragma unroll
          for (int ni = 0; ni < 4; ++ni) { float4 g = *(const float4*)(nw + ni * 16 + c4);
            v[ni][0] *= rs * g.x; v[ni][1] *= rs * g.y; v[ni][2] *= rs * g.z; v[ni][3] *= rs * g.w; }
          if (rope && lat) {
            const int t = row & 8191, pr = t >> 6, pc = t & 63;
#pragma unroll
            for (int r = 0; r < 4; ++r) {
              float2 a = t64[pr * 16 + c4 + r]; float x1 = v[0][r], x2 = v[2][r]; v[0][r] = x1 * a.x - x2 * a.y; v[2][r] = x1 * a.y + x2 * a.x;
              float2 b = t64[pc * 16 + c4 + r]; x1 = v[1][r]; x2 = v[3][r]; v[1][r] = x1 * b.x - x2 * b.y; v[3][r] = x1 * b.y + x2 * b.x;
            }
          }
        }
#pragma unroll
        for (int ni = 0; ni < 4; ++ni) { const int col = wr * 64 + ni * 16 + c4;
          if (col < ncols) { if (nt >= 30) st4_wt(dst + (size_t)row * ldd + dcol + col, v[ni][0], v[ni][1], v[ni][2], v[ni][3]);
                             else st4(dst + (size_t)row * ldd + dcol + col, v[ni][0], v[ni][1], v[ni][2], v[ni][3]); } }
      }
  }
  if (nt2 == 15 || nt2 == 16) publish_drained(hand_ctr(p, l, mt < NLAT / BM ? 0 : 1 + mt - NLAT / BM), tid);
}

DEVI int p2_next(int l, int it, int& mt, int& nt) {
  constexpr int NMAIN = (NLAT / BM) * 33;
  if (it < NMAIN) { xcd_tile(it, NLAT / BM, 33, mt, nt); nt += 15; if (nt >= 33) nt -= 33; return it; }
  const int j = it - NMAIN, nseg = (l == 0) ? 33 : 17;
  if (j >= 2 * nseg) return -1;
  mt = NLAT / BM + (j & 1); nt = (j >> 1) + 15; if (nt >= nseg) nt -= nseg;
  return it;
}
DEVI void phase2(CPR p, int l, char* lds) {
  int mt = 0, nt = 0, it = p2_next(l, blockIdx.x, mt, nt);
  if (it < 0) return;
  { f32x4 dummy[2][2][4][2]; const int tid = TID();
    gemm256<false, 1>(dummy, (const u16*)(p.ws + OFF_WT + (size_t)l * WT_LAYER + WT_WIN) + (size_t)nt * 256 * 1024, 1024, (const u16*)(p.ws + OFF_H) + (size_t)mt * BM * 1024, [&](int r) { return r * 1024; }, 1024, lds, tid); }
  while (it >= 0) {
    int mtN = 0, ntN = 0; const int itN = p2_next(l, it + gridDim.x, mtN, ntN);
    p2_item(p, l, mt, nt, itN >= 0, mtN, ntN, lds);
    it = itN; mt = mtN; nt = ntN;
  }
}

template <int KD>
DEVI void p3_rowscale(const u16* tmp_rows  , float* rsA, int tid) {
  const int row = tid >> 1, half = tid & 1; const u16* s = tmp_rows + (size_t)row * TMPLD + half * (KD / 2);
  float ss = 0;
#pragma unroll
  for (int i = 0; i < KD / 16; ++i) { uint4 u = *(const uint4*)(s + i * 8);
    ss += lo_f(u.x) * lo_f(u.x) + hi_f(u.x) * hi_f(u.x) + lo_f(u.y) * lo_f(u.y) + hi_f(u.y) * hi_f(u.y) + lo_f(u.z) * lo_f(u.z) + hi_f(u.z) * hi_f(u.z) + lo_f(u.w) * lo_f(u.w) + hi_f(u.w) * hi_f(u.w); }
  ss += shx(ss, 1);
  if (half == 0) rsA[row] = rsqrtf(ss * (1.f / (float)KD) + EPS);
}
DEVI void p3_item(CPR p, int l, int item, char* lds) {
  const int tid = TID(), lane = tid & 63, wave = tid >> 6;
  const int mt = item >> 4, hh = (item ^ ((item >> 8) << 3)) & 15;
  const u16* TMP = (const u16*)(p.ws + OFF_TMP);
  float* rsA = (float*)(lds + 98304);
  const bool lat = mt < NLAT / BM; const int q = lane >> 4, c4 = q * 4;
  const float2* t32 = (const float2*)(p.ws + OFF_TAB32);
  if (hh < 8) {
    const int h = hh;
    p3_rowscale<256>(TMP + (size_t)mt * BM * TMPLD, rsA, tid);
    f32x4 acc[6][2];
#pragma unroll
    for (int a = 0; a < 6; ++a) { acc[a][0] = f32x4{0, 0, 0, 0}; acc[a][1] = f32x4{0, 0, 0, 0}; }
    const u16* Wt = (const u16*)(p.ws + OFF_WT + (size_t)l * WT_LAYER + WT_WQB) + (size_t)h * 96 * 256;
    gemm_tile<96, 8, 1>(acc, [&](int r) { return TMP + (size_t)(mt * BM + r) * TMPLD; }, Wt, 256, 256, lds, tid);
    const float* gq = p.in[I_MQN] + l * 96; u16* MQ = (u16*)(p.ws + OFF_MQ);
#pragma unroll
    for (int mi = 0; mi < 2; ++mi) {
      const int rl = wave * 32 + mi * 16 + (lane & 15), row = mt * BM + rl; const float ra = rsA[rl];
      float v[6][4]; float ss = 0;
#pragma unroll
      for (int ni = 0; ni < 6; ++ni)
#pragma unroll
        for (int r = 0; r < 4; ++r) { v[ni][r] = acc[ni][mi][r] * ra; ss += v[ni][r] * v[ni][r]; }
      ss += shx(ss, 16); ss += shx(ss, 32);
      const float rs = rsqrtf(ss * (1.f / 96.f) + EPS) * (0.10206207261596575f * LOG2E);
#pragma unroll
      for (int ni = 0; ni < 6; ++ni) { float4 g = *(const float4*)(gq + ni * 16 + c4);
        v[ni][0] *= rs * g.x; v[ni][1] *= rs * g.y; v[ni][2] *= rs * g.z; v[ni][3] *= rs * g.w; }
      if (lat) {
        const int t = row & 8191; const int pos = (q < 2) ? (t >> 6) : (t & 63);
#pragma unroll
        for (int r = 0; r < 4; ++r) { float2 a = t32[pos * 8 + (q & 1) * 4 + r]; float x1 = v[4][r], x2 = v[5][r]; v[4][r] = x1 * a.x - x2 * a.y; v[5][r] = x1 * a.y + x2 * a.x; }
      }
#pragma unroll
      for (int ni = 0; ni < 6; ++ni) st4(MQ + (size_t)row * 768 + h * 96 + ni * 16 + c4, v[ni][0], v[ni][1], v[ni][2], v[ni][3]);
    }
  } else {
    const int h = hh - 8;
    p3_rowscale<128>(TMP + (size_t)mt * BM * TMPLD + 256, rsA, tid);
    f32x4 acc[8][2];
#pragma unroll
    for (int a = 0; a < 8; ++a) { acc[a][0] = f32x4{0, 0, 0, 0}; acc[a][1] = f32x4{0, 0, 0, 0}; }
    const u16* Wt = (const u16*)(p.ws + OFF_WT + (size_t)l * WT_LAYER + WT_WKVB) + (size_t)h * 128 * 128;
    gemm_tile<128, 8, 1>(acc, [&](int r) { return TMP + (size_t)(mt * BM + r) * TMPLD + 256; }, Wt, 128, 128, lds, tid);
    const float* gk = p.in[I_MKN] + l * 96; u16* MK = (u16*)(p.ws + OFF_MK); u16* MV = (u16*)(p.ws + OFF_MV);
#pragma unroll
    for (int mi = 0; mi < 2; ++mi) {
      const int rl = wave * 32 + mi * 16 + (lane & 15), row = mt * BM + rl; const float ra = rsA[rl];
      float kn[4][4], kr0[4], kr1[4]; float ss = 0;
#pragma unroll
      for (int ni = 0; ni < 4; ++ni)
#pragma unroll
        for (int r = 0; r < 4; ++r) { kn[ni][r] = acc[ni][mi][r] * ra; ss += kn[ni][r] * kn[ni][r]; }
      { uint2 a = *(const uint2*)(TMP + (size_t)row * TMPLD + 384 + c4), b = *(const uint2*)(TMP + (size_t)row * TMPLD + 400 + c4);
        kr0[0] = lo_f(a.x); kr0[1] = hi_f(a.x); kr0[2] = lo_f(a.y); kr0[3] = hi_f(a.y);
        kr1[0] = lo_f(b.x); kr1[1] = hi_f(b.x); kr1[2] = lo_f(b.y); kr1[3] = hi_f(b.y); }
#pragma unroll
      for (int r = 0; r < 4; ++r) ss += kr0[r] * kr0[r] + kr1[r] * kr1[r];
      ss += shx(ss, 16); ss += shx(ss, 32);
      const float rs = rsqrtf(ss * (1.f / 96.f) + EPS);
#pragma unroll
      for (int ni = 0; ni < 4; ++ni) { float4 g = *(const float4*)(gk + ni * 16 + c4);
        kn[ni][0] *= rs * g.x; kn[ni][1] *= rs * g.y; kn[ni][2] *= rs * g.z; kn[ni][3] *= rs * g.w; }
      { float4 g0 = *(const float4*)(gk + 64 + c4), g1 = *(const float4*)(gk + 80 + c4);
        kr0[0] *= rs * g0.x; kr0[1] *= rs * g0.y; kr0[2] *= rs * g0.z; kr0[3] *= rs * g0.w;
        kr1[0] *= rs * g1.x; kr1[1] *= rs * g1.y; kr1[2] *= rs * g1.z; kr1[3] *= rs * g1.w; }
      if (lat) {
        const int t = row & 8191; const int pos = (q < 2) ? (t >> 6) : (t & 63);
#pragma unroll
        for (int r = 0; r < 4; ++r) { float2 a = t32[pos * 8 + (q & 1) * 4 + r]; float x1 = kr0[r], x2 = kr1[r]; kr0[r] = x1 * a.x - x2 * a.y; kr1[r] = x1 * a.y + x2 * a.x; }
      }
      u16* mk = MK + (size_t)row * 768 + h * 96;
#pragma unroll
      for (int ni = 0; ni < 4; ++ni) st4(mk + ni * 16 + c4, kn[ni][0], kn[ni][1], kn[ni][2], kn[ni][3]);
      st4(mk + 64 + c4, kr0[0], kr0[1], kr0[2], kr0[3]); st4(mk + 80 + c4, kr1[0], kr1[1], kr1[2], kr1[3]);
#pragma unroll
      for (int ni = 4; ni < 8; ++ni) st4(MV + (size_t)row * 512 + h * 64 + (ni - 4) * 16 + c4, acc[ni][mi][0] * ra, acc[ni][mi][1] * ra, acc[ni][mi][2] * ra, acc[ni][mi][3] * ra);
    }
  }
}

DEVI int p3_tail_item(int l, int k, int& cnt) {
  const int n = (NROW / BM) * 16, G = (int)gridDim.x, b = (int)blockIdx.x;
  if (G != 256) { cnt = (n - b + G - 1) / G; return b + G * k; }
  const int nh = (l == 0) ? 130 : 98, xh = 3;
  if (b < nh) { cnt = xh; return b + nh * k; }
  const int j = b - nh, nl = 256 - nh, R = n - nh * xh;
  cnt = R / nl + (j < R % nl ? 1 : 0);
  return nh * xh + j + nl * k;
}
DEVI void phase3_tail(CPR p, int l, char* lds) {
#pragma unroll 1
  for (int k = 0;; ++k) {
    int cnt; const int idx = p3_tail_item(l, k, cnt);
    if (k >= cnt) break;
    const int mt = idx >> 4;
#pragma unroll 1
    for (int w = 0; w < 2; ++w) {
      const bool need = (w == 0) ? (k == 0) : (mt >= NLAT / BM);
      if (need) wait_ctr(hand_ctr(p, l, w == 0 ? 0 : 1 + mt - NLAT / BM), w == 0 ? 2u * (NLAT / BM) : 2u, (unsigned*)(p.ws + OFF_BAR) + 128, TID());
    }
    p3_item(p, l, idx, lds);
  }
}

constexpr int VBLK = 64 * 64;
typedef short s16x4_t __attribute__((ext_vector_type(4)));
DEVI bf16x4 tr_read(const char* p) { return __builtin_amdgcn_ds_read_tr16_b64_v4i16((__attribute__((address_space(3))) s16x4_t*)(p)); }
template <int DK, int KL, int DV, int QB, class PF, class MID>
DEVI void attn_tile_compute(const char* Ks, const char* Vs, const bf16x8 (&qf)[QB][DK / 16], f32x16 (&o)[QB][DV / 32], float (&lsum)[QB], PF pf, int lane, int isel, MID mid) {
  const int r32 = lane & 31, hi = lane >> 5;
  const char* vlane = Vs + (((lane & 15) >> 2) + 4 * hi) * 64 + (16 * ((lane >> 4) & 1) + 4 * (lane & 3)) * 2;
  auto qk = [&](int kb, f32x16 (&s)[QB]) {
#pragma unroll
    for (int qb = 0; qb < QB; ++qb)
#pragma unroll
      for (int r = 0; r < 16; ++r) s[qb][r] = 0.f;
#pragma unroll
    for (int ks = 0; ks < DK / 16; ++ks) {
      const char* ap;
      if (KL == 1) ap = Ks + (kb * 32 + r32) * 256 + (((isel * 8 + ks * 2 + hi) ^ (r32 & 15)) << 4);
      else if (KL == 2 && ks >= 4) ap = Ks + 8192 + (kb * 32 + r32) * 64 + ((((ks - 4) * 2 + hi) ^ ((r32 >> 2) & 3)) << 4);
      else ap = Ks + (kb * 32 + r32) * 128 + (((ks * 2 + hi) ^ ((r32 >> 1) & 7)) << 4);
      bf16x8 a = *(const bf16x8*)ap;
#pragma unroll
      for (int qb = 0; qb < QB; ++qb) s[qb] = __builtin_amdgcn_mfma_f32_32x32x16_bf16(a, qf[qb][ks], s[qb], 0, 0, 0);
    }
  };
  auto softmax = [&](const f32x16& s, int kb, int qb, bf16x8 (&pb)[2]) {
    float pv[16];
#pragma unroll
    for (int r = 0; r < 16; ++r) { const int key = kb * 32 + (r & 3) + 8 * (r >> 2) + 4 * hi; pv[r] = pf(qb, s[r], key); lsum[qb] += pv[r]; }
#pragma unroll
    for (int s2 = 0; s2 < 2; ++s2) {
      u32x4 w = {pk2(pv[8 * s2 + 0], pv[8 * s2 + 1]), pk2(pv[8 * s2 + 2], pv[8 * s2 + 3]), pk2(pv[8 * s2 + 4], pv[8 * s2 + 5]), pk2(pv[8 * s2 + 6], pv[8 * s2 + 7])};
      pb[s2] = __builtin_bit_cast(bf16x8, w);
    }
  };
  auto ldv = [&](int kb, int i) {
    const char* vp = vlane + (i % (DV / 32)) * VBLK + (kb * 32 + (i / (DV / 32)) * 16) * 64;
    const bf16x4 v0 = tr_read(vp), v1 = tr_read(vp + 8 * 64);
    const bf16x8 va = {v0[0], v0[1], v0[2], v0[3], v1[0], v1[1], v1[2], v1[3]};
    return va;
  };
  auto pvmm = [&](int kb, const bf16x8 (&pb)[QB][2]) {
    constexpr int NF = 2 * (DV / 32);
    bf16x8 va = ldv(kb, 0);
#pragma unroll
    for (int i = 0; i < NF; ++i) {
      bf16x8 vn = va;
      if (i + 1 < NF) vn = ldv(kb, i + 1);
#pragma unroll
      for (int qb = 0; qb < QB; ++qb) o[qb][i % (DV / 32)] = __builtin_amdgcn_mfma_f32_32x32x16_bf16(va, pb[qb][i / (DV / 32)], o[qb][i % (DV / 32)], 0, 0, 0);
      va = vn;
    }
  };
  if (QB >= 2) {
    bf16x8 p0[QB][2];
#pragma unroll
    for (int kb = 0; kb < 2; ++kb) {
      f32x16 s0[QB];
      qk(kb, s0);
      if (kb == 0) mid();
#pragma unroll
      for (int qb = 0; qb < QB; ++qb) softmax(s0[qb], kb, qb, p0[qb]);
      pvmm(kb, p0);
    }
    return;
  }
  f32x16 s0[QB], s1[QB];
  qk(0, s0);
  qk(1, s1);
  bf16x8 p0[QB][2], p1[QB][2];
#pragma unroll
  for (int qb = 0; qb < QB; ++qb) softmax(s0[qb], 0, qb, p0[qb]);
  pvmm(0, p0);
  mid();
#pragma unroll
  for (int qb = 0; qb < QB; ++qb) softmax(s1[qb], 1, qb, p1[qb]);
  pvmm(1, p1);
}

enum { AM_DENSE = 0, AM_WIN = 1, AM_NAT = 2 };
DEVI int nat_rstart(int r) { int s = r - 4; s = s < 0 ? 0 : s; return s > 120 ? 120 : s; }

template <int DK, int DKT, int DV, int MODE, bool DIF, int QB, bool SHIFT>
DEVI void attn_block(const u16* Qp, int ldq, const u16* __restrict__ Kp, int ldk, const u16* __restrict__ Vp, int ldv,
                     u16* Op, int ldo, int b, bool latq, int qpos0, float M2, float sinkterm,
                     const float* __restrict__ rpb, float lam, const float* __restrict__ subln, float oscale, char* lds) {
  constexpr int KL = (DKT == 64) ? 0 : (DKT == 128 ? 1 : 2);
  M2 = rflf(M2); sinkterm = rflf(sinkterm); lam = rflf(lam); oscale = rflf(oscale);
  constexpr int KBYTES = 64 * DKT * 2, VBYTES = (DV / 32) * VBLK, BUFB = KBYTES + VBYTES, NPW = (BUFB + 8191) / 8192;
  constexpr int NQ = (DIF ? 128 : 256) * QB;
  const int tid = TID(), lane = tid & 63, wave = __builtin_amdgcn_readfirstlane(tid >> 6), r32 = lane & 31, hi = lane >> 5;
  float* rpbs = (float*)(lds + 2 * BUFB);
  const int qbase = DIF ? ((wave & 3) * 32 * QB) : (wave * 32 * QB);
  const int isel = DIF ? (wave >> 2) : 0;
  bf16x8 qf[QB][DK / 16];
#pragma unroll
  for (int qb = 0; qb < QB; ++qb) {
    const u16* qrow = Qp + (size_t)(qbase + qb * 32 + r32) * ldq + isel * 64 + hi * 8;
#pragma unroll
    for (int ks = 0; ks < DK / 16; ++ks) qf[qb][ks] = *(const bf16x8*)(qrow + ks * 16);
  }
  int NT = 4, lo = 0;
  if (MODE == AM_DENSE) { NT = latq ? 4 + SEQ / 64 : 4; }
  else if (MODE == AM_WIN) { if (latq) { const int nb0 = qpos0 >> 7, nb1 = (qpos0 + NQ - 1) >> 7; lo = nb0 > 0 ? nb0 - 1 : 0; const int hb = nb1 < 63 ? nb1 + 1 : 63; NT = 4 + (hb - lo + 1) * 2; lo *= 128; } }
  else { const int r0 = qpos0 >> 6, r1 = (qpos0 + NQ - 1) >> 6; lo = nat_rstart(r0); NT = 4 + (nat_rstart(r1) + 7 - lo + 1); lo *= 64; }
  auto tile_row0 = [&](int t) { return t < 4 ? NLAT + b * CTXL + t * 64 : b * SEQ + lo + (t - 4) * 64; };
  if (MODE == AM_NAT) { for (int i = tid; i < 704; i += NTHR) { const int k = i - 128; rpbs[i] = (k >= 0 && k < 465) ? rpb[k] * LOG2E - (SHIFT ? M2 : 0.f) : 0.f; } }
  const int qpos = qpos0 + qbase + r32;
  const int qr = (qpos0 + qbase) >> 6, jq = qpos & 63;
  const int rsq = nat_rstart(qr);
  unsigned soff[NPW];
#pragma unroll
  for (int i = 0; i < NPW; ++i) {
    const int pc = i * NW + wave;
    if (pc * 1024 < KBYTES) {
      if (KL == 1) { const int row = pc * 4 + (lane >> 4), c = (lane & 15) ^ (row & 15); soff[i] = (unsigned)(row * ldk + c * 8) * 2u; }
      else if (KL == 2 && pc >= 8) { const int row = (pc - 8) * 16 + (lane >> 2), c = (lane & 3) ^ ((row >> 2) & 3); soff[i] = (unsigned)(row * ldk + 64 + c * 8) * 2u; }
      else { const int row = pc * 8 + (lane >> 3), c = (lane & 7) ^ ((row >> 1) & 7); soff[i] = (unsigned)(row * ldk + c * 8) * 2u; }
    } else {
      const int pv = pc - KBYTES / 1024, blk = pv >> 2, key = (pv & 3) * 16 + (lane >> 2);
      soff[i] = (unsigned)(key * ldv + blk * 32 + (lane & 3) * 8) * 2u;
    }
  }
  auto issue = [&](int t, int buf) {
    const int row0 = tile_row0(t);
    const u16* kb_ = Kp + (size_t)row0 * ldk; const u16* vb_ = Vp + (size_t)row0 * ldv;
    char* dst = lds + buf * BUFB + wave * 1024;
#pragma unroll
    for (int i = 0; i < NPW; ++i) { const int pc = i * NW + wave;
      if (KL == 1) {
        const char* sb_ = (const char*)(i < 2 ? kb_ + (size_t)(i * 32) * ldk : vb_ + (i - 2) * 64);
        asm volatile("" : "+s"(sb_));
        glds16(sb_ + (size_t)soff[i < 2 ? 0 : 2], dst + i * 8192);
      } else if (pc * 1024 < BUFB) { const char* sb_ = (const char*)(pc * 1024 < KBYTES ? kb_ : vb_); asm volatile("" : "+s"(sb_)); glds16(sb_ + (size_t)soff[i], dst + i * 8192); } }
  };
  f32x16 o[QB][DV / 32];
#pragma unroll
  for (int qb = 0; qb < QB; ++qb)
#pragma unroll
    for (int i = 0; i < DV / 32; ++i)
#pragma unroll
      for (int r = 0; r < 16; ++r) o[qb][i][r] = 0.f;
  float lsum[QB];
#pragma unroll
  for (int qb = 0; qb < QB; ++qb) lsum[qb] = 0.f;
  issue(0, 0);
  asm volatile("s_waitcnt vmcnt(0)" ::: "memory");
  __syncthreads();
  if (wave < 4) __builtin_amdgcn_s_setprio(2);
  for (int t = 0; t < NT; ++t) {
    const char* Ks = lds + (t & 1) * BUFB; const char* Vs = Ks + KBYTES;
    if (MODE != AM_DENSE && t + 1 < NT) issue(t + 1, (t + 1) & 1);
    if (MODE == AM_DENSE || t < 4) {
      attn_tile_compute<DK, KL, DV, QB>(Ks, Vs, qf, o, lsum, [&](int, float s, int) { return SHIFT ? fexp2(s - M2) : fexp2(s); }, lane, isel,
                                        [&]() { if (MODE == AM_DENSE && t + 1 < NT) issue(t + 1, (t + 1) & 1); });
    } else if (MODE == AM_WIN) {
      const int kpt = lo + (t - 4) * 64, wq_lo = qpos0 + qbase;
      if (kpt + 63 >= wq_lo - 128 && kpt <= wq_lo + 32 * QB - 1 + 128) {
        const int kp0 = kpt - qpos;
        attn_tile_compute<DK, KL, DV, QB>(Ks, Vs, qf, o, lsum, [&](int qb, float s, int key) { const int d = kp0 + key - qb * 32; const float e = SHIFT ? fexp2(s - M2) : fexp2(s); return (d <= 128 && d >= -128) ? e : 0.f; }, lane, isel, []() {});
      }
    } else {
      const int kr = (lo >> 6) + (t - 4);
      if (kr >= rsq && kr < rsq + 8) {
        int cs[QB];
#pragma unroll
        for (int qb = 0; qb < QB; ++qb) { int c = jq + 32 * qb - 8; cs[qb] = c < 0 ? 0 : (c > 48 ? 48 : c); }
        const float* bl = rpbs + 128 + (kr - qr + 7) * 31 + 15 - jq;
        attn_tile_compute<DK, KL, DV, QB>(Ks, Vs, qf, o, lsum, [&](int qb, float s, int key) {
          const bool ok = (unsigned)(key - cs[qb]) < 16u;
          const float e = fexp2(s + bl[key - 32 * qb]); return ok ? e : 0.f; }, lane, isel, []() {});
      }
    }
    asm volatile("s_waitcnt vmcnt(0)" ::: "memory");
    __syncthreads();
  }
  __builtin_amdgcn_s_setprio(0);
  if (!DIF) {
    const int lane_e = lane_opaque(), r32e = lane_e & 31, hie = lane_e >> 5;
#pragma unroll
    for (int qb = 0; qb < QB; ++qb) {
      const float ltot = lsum[qb] + shx(lsum[qb], 32) + sinkterm;
      const float inv = 1.f / ltot;
      u16* orow = Op + (size_t)(qbase + qb * 32 + r32e) * ldo;
#pragma unroll
      for (int blk = 0; blk < DV / 32; ++blk)
#pragma unroll
        for (int g = 0; g < 4; ++g) st4(orow + blk * 32 + 8 * g + 4 * hie, o[qb][blk][4 * g] * inv, o[qb][blk][4 * g + 1] * inv, o[qb][blk][4 * g + 2] * inv, o[qb][blk][4 * g + 3] * inv);
    }
  } else {
    float* ex = (float*)lds;
    float inv[QB];
#pragma unroll
    for (int qb = 0; qb < QB; ++qb) inv[qb] = 1.f / (lsum[qb] + shx(lsum[qb], 32));
    if (isel == 1) {
#pragma unroll
      for (int qb = 0; qb < QB; ++qb) { const int qloc = qbase + qb * 32 + r32;
#pragma unroll
        for (int blk = 0; blk < DV / 32; ++blk)
#pragma unroll
          for (int g = 0; g < 4; ++g) *(float4*)(ex + qloc * 132 + blk * 32 + 8 * g + 4 * hi) = make_float4(o[qb][blk][4 * g] * inv[qb], o[qb][blk][4 * g + 1] * inv[qb], o[qb][blk][4 * g + 2] * inv[qb], o[qb][blk][4 * g + 3] * inv[qb]); }
    }
    __syncthreads();
    if (isel == 0) {
#pragma unroll
      for (int qb = 0; qb < QB; ++qb) { const int qloc = qbase + qb * 32 + r32;
        float ss = 0;
#pragma unroll
        for (int blk = 0; blk < DV / 32; ++blk)
#pragma unroll
          for (int g = 0; g < 4; ++g) { float4 o1 = *(const float4*)(ex + qloc * 132 + blk * 32 + 8 * g + 4 * hi);
            float a0 = o[qb][blk][4 * g] * inv[qb] - lam * o1.x, a1 = o[qb][blk][4 * g + 1] * inv[qb] - lam * o1.y, a2 = o[qb][blk][4 * g + 2] * inv[qb] - lam * o1.z, a3 = o[qb][blk][4 * g + 3] * inv[qb] - lam * o1.w;
            o[qb][blk][4 * g] = a0; o[qb][blk][4 * g + 1] = a1; o[qb][blk][4 * g + 2] = a2; o[qb][blk][4 * g + 3] = a3; ss += a0 * a0 + a1 * a1 + a2 * a2 + a3 * a3; }
        ss += shx(ss, 32);
        const float rs = rsqrtf(ss * (1.f / 128.f) + EPS) * oscale;
        u16* orow = Op + (size_t)qloc * ldo;
#pragma unroll
        for (int blk = 0; blk < DV / 32; ++blk)
#pragma unroll
          for (int g = 0; g < 4; ++g) { const int dv0 = blk * 32 + 8 * g + 4 * hi; float4 sl = *(const float4*)(subln + dv0);
            st4(orow + dv0, o[qb][blk][4 * g] * rs * sl.x, o[qb][blk][4 * g + 1] * rs * sl.y, o[qb][blk][4 * g + 2] * rs * sl.z, o[qb][blk][4 * g + 3] * rs * sl.w); }
      }
    }
    __syncthreads();
  }
}

template <int KIND>
DEVI void p4_item(CPR p, int l, int i, char* lds) {
  const float* cst = (const float*)(p.ws + OFF_CONST) + l * 32;
  constexpr bool latq = KIND < 4;
  int b, h, q0, qpos0;
  if (KIND == 0) { b = i / (256 / DQB); h = (i / (64 / DQB)) & 3; qpos0 = (i % (64 / DQB)) * 128 * DQB; }
  else if (KIND == 1) { b = i >> 7; h = (i >> 4) & 7; qpos0 = (i & 15) * 512; }
  else if (KIND < 4) { constexpr int QB_ = (KIND == 3) ? NWQB : 1; b = i / (256 / QB_); h = (i / (32 / QB_)) & 7; qpos0 = (i % (32 / QB_)) * 256 * QB_; }
  else if (KIND == 5) { b = i >> 3; h = (i >> 1) & 3; qpos0 = (i & 1) * 128; }
  else { b = i >> 3; qpos0 = 0; h = i & 7; }
  q0 = latq ? b * SEQ + qpos0 : NLAT + b * CTXL + qpos0;
  if (KIND == 0 || KIND == 5) {
    u16* DQ = (u16*)(p.ws + OFF_DQ); const u16* DKb = (const u16*)(p.ws + OFF_DK); const u16* DVb = (const u16*)(p.ws + OFF_DV);
    const float M2 = cst[3] * LOG2E;
#define ATTN_DIF(SH, MM) attn_block<64, 128, 128, AM_DENSE, true, (KIND == 0 ? DQB : 1), SH>(DQ + (size_t)q0 * 512 + h * 128, 512, DKb + h * 128, 512, DVb + h * 128, 512, (u16*)(p.ws + ys_off(1)) + (size_t)q0 * 512 + h * 128, 512, \
        b, latq, qpos0, MM, 0.f, nullptr, cst[0], p.in[I_SUBLN] + l * 128, 1.f - cst[1], lds)
    if (M2 > 64.f) ATTN_DIF(true, M2); else ATTN_DIF(false, 0.f);
#undef ATTN_DIF
  } else if (KIND == 1 || KIND == 7) {
    const u16* MQ = (const u16*)(p.ws + OFF_MQ); const u16* MK = (const u16*)(p.ws + OFF_MK); const u16* MV = (const u16*)(p.ws + OFF_MV);
    const float M2 = cst[5] * LOG2E;
#define ATTN_MLA(SH, MM) attn_block<96, 96, 64, AM_DENSE, false, (KIND == 1 ? 2 : 1), SH>(MQ + (size_t)q0 * 768 + h * 96, 768, MK + h * 96, 768, MV + h * 64, 512, (u16*)(p.ws + ys_off(3)) + (size_t)q0 * 512 + h * 64, 512, \
        b, latq, qpos0, MM, 0.f, nullptr, 0.f, nullptr, 0.f, lds)
    if (M2 > 64.f) ATTN_MLA(true, M2); else ATTN_MLA(false, 0.f);
#undef ATTN_MLA
  } else if (KIND == 2) {
    u16* NQ = (u16*)(p.ws + OFF_NQ); const u16* NK = (const u16*)(p.ws + OFF_NK); const u16* NV = (const u16*)(p.ws + OFF_NV);
    const float M2 = (cst[4] + cst[8 + h]) * LOG2E;
#define ATTN_NAT(SH, MM) attn_block<64, 64, 64, AM_NAT, false, 1, SH>(NQ + (size_t)q0 * 512 + h * 64, 512, NK + h * 64, 512, NV + h * 64, 512, (u16*)(p.ws + ys_off(2)) + (size_t)q0 * 512 + h * 64, 512, \
        b, true, qpos0, MM, 0.f, p.in[I_RPB] + (size_t)(l * 8 + h) * 465, 0.f, nullptr, 0.f, lds)
    if (M2 > 64.f) ATTN_NAT(true, M2); else ATTN_NAT(false, 0.f);
#undef ATTN_NAT
  } else if (KIND == 6) {
    u16* NQ = (u16*)(p.ws + OFF_NQ); const u16* NK = (const u16*)(p.ws + OFF_NK); const u16* NV = (const u16*)(p.ws + OFF_NV);
    const float M2 = cst[4] * LOG2E;
#define ATTN_NATC(SH, MM) attn_block<64, 64, 64, AM_DENSE, false, AQB, SH>(NQ + (size_t)q0 * 512 + h * 64, 512, NK + h * 64, 512, NV + h * 64, 512, (u16*)(p.ws + ys_off(2)) + (size_t)q0 * 512 + h * 64, 512, \
        b, false, qpos0, MM, 0.f, nullptr, 0.f, nullptr, 0.f, lds)
    if (M2 > 64.f) ATTN_NATC(true, M2); else ATTN_NATC(false, 0.f);
#undef ATTN_NATC
  } else {
    u16* WQ = (u16*)(p.ws + OFF_WQ); const u16* WK = (const u16*)(p.ws + OFF_WK); const u16* WV = (const u16*)(p.ws + OFF_WV);
    const float sk = p.in[I_SINK][l * 8 + h]; const float M = fmaxf(cst[2], sk); const float M2 = M * LOG2E;
#define ATTN_WIN(SH, MM) attn_block<64, 64, 64, AM_WIN, false, (KIND == 3 ? NWQB : 1), SH>(WQ + (size_t)q0 * 512 + h * 64, 512, WK + (h >> 2) * 64, 128, WV + (h >> 2) * 64, 128, (u16*)(p.ws + ys_off(0)) + (size_t)q0 * 512 + h * 64, 512, \
        b, latq, qpos0, MM, fexp2(sk * LOG2E - MM), nullptr, 0.f, nullptr, 0.f, lds)
    if (M2 > 64.f) ATTN_WIN(true, M2); else ATTN_WIN(false, 0.f);
#undef ATTN_WIN
  }
}
template <int KIND>
DEVI void p4_loop(CPR p, int l, int n, int start, char* lds) {
  for (int rep = 0; rep < 1 + ((REP_KIND >> KIND) & 1); ++rep)
    for (int idx = (blockIdx.x + start) % gridDim.x; idx < n; idx += gridDim.x) {
      int it = idx;
      if (KIND < 4) {
        constexpr int Q = (KIND == 0) ? 64 / DQB : (KIND == 1 ? 16 : (KIND == 3 ? 32 / NWQB : 32));
        const int x = idx & 7, y = idx >> 3; it = (x + 8 * (y / Q)) * Q + (y % Q);
      }
      p4_item<KIND>(p, l, it, lds);
    }
}
DEVI void phase4(CPR p, int l, char* lds) {
  p4_loop<0>(p, l, 512 / DQB, 0, lds);
  p4_loop<1>(p, l, 256, 0, lds);
  p4_loop<2>(p, l, 512, 0, lds);
  p4_loop<3>(p, l, 512 / NWQB, 0, lds);
  if (l == 0) {
    p4_loop<4>(p, l, 16, 0, lds);
    p4_loop<5>(p, l, 16, gridDim.x - 16, lds);
    p4_loop<6>(p, l, 16, gridDim.x - 32, lds);
    p4_loop<7>(p, l, 16, gridDim.x - 48, lds);
  }
}

DEVI void p5_item64(CPR p, int l, int item, char* lds) {
  const int tid = TID(), lane = tid & 63, wave = tid >> 6, wm = wave >> 1, wn = wave & 1;
  const int mt = item >> 4, dt = item & 15;
  const u16* H = (const u16*)(p.ws + OFF_H);
  const char* wt = p.ws + OFF_WT + (size_t)l * WT_LAYER;
  f32x4 m[2][4];
#pragma unroll
  for (int a = 0; a < 2; ++a)
#pragma unroll
    for (int b = 0; b < 4; ++b) m[a][b] = f32x4{0, 0, 0, 0};
  static_assert(OFF_DQ == OFF_WQ + SZ512 && OFF_NQ == OFF_WQ + 2 * SZ512 && OFF_YD == OFF_WQ + 3 * SZ512, "ys buffers must be contiguous");
#pragma unroll 1
  for (int n = 0; n < 4; ++n) {
    if (!((BRANCH_MASK >> n) & 1)) continue;
    f32x4 y[2][4]; unsigned g8[2][4];
#pragma unroll
    for (int a = 0; a < 2; ++a)
#pragma unroll
      for (int b = 0; b < 4; ++b) { y[a][b] = f32x4{0, 0, 0, 0};
        g8[a][b] = *(const unsigned*)(gate_row(p, l, mt * BM + wm * 64 + b * 16 + (lane & 15)) + n * 1024 + dt * 64 + wn * 32 + a * 16 + (lane >> 4) * 4); }
    const u16* ys = (const u16*)(p.ws + ys_off(n));
    gemm_tile<64, 4, 2, 3>(y, [&](int r) { return ys + (size_t)(mt * BM + r) * 512; }, (const u16*)(wt + WT_WB) + (size_t)(n * 1024 + dt * 64) * 512, 512, 512, lds, tid);
#pragma unroll
    for (int a = 0; a < 2; ++a)
#pragma unroll
      for (int b = 0; b < 4; ++b)
#pragma unroll
        for (int r = 0; r < 4; ++r) m[a][b][r] += (float)((g8[a][b] >> (8 * r)) & 255u) * y[a][b][r];
  }
  u16* M = (u16*)(p.ws + OFF_M);
#pragma unroll
  for (int mi = 0; mi < 4; ++mi) { const int row = mt * BM + wm * 64 + mi * 16 + (lane & 15);
#pragma unroll
    for (int ni = 0; ni < 2; ++ni) st4(M + (size_t)row * 1024 + dt * 64 + wn * 32 + ni * 16 + (lane >> 4) * 4, m[ni][mi][0] * (1.f / 255.f), m[ni][mi][1] * (1.f / 255.f), m[ni][mi][2] * (1.f / 255.f), m[ni][mi][3] * (1.f / 255.f)); }
}

DEVI void p5_item128(CPR p, int l, int mt, int nt, char* lds) {
  const int tid = TID(), lane = tid & 63, wave = tid >> 6, wm = wave >> 1, wn = wave & 1;
  const u16* H = (const u16*)(p.ws + OFF_H);
  const char* wt = p.ws + OFF_WT + (size_t)l * WT_LAYER;
  f32x4 m[4][4];
#pragma unroll
  for (int a = 0; a < 4; ++a)
#pragma unroll
    for (int b = 0; b < 4; ++b) m[a][b] = f32x4{0, 0, 0, 0};
#pragma unroll 1
  for (int n = 0; n < 4; ++n) {
    if (!((BRANCH_MASK >> n) & 1)) continue;
    unsigned g8[4][4];
    f32x4 y[4][4];
#pragma unroll
    for (int a = 0; a < 4; ++a)
#pragma unroll
      for (int b = 0; b < 4; ++b) { y[a][b] = f32x4{0, 0, 0, 0};
        g8[a][b] = *(const unsigned*)(gate_row(p, l, mt * BM + wm * 64 + b * 16 + (lane & 15)) + n * 1024 + nt * 128 + wn * 64 + a * 16 + (lane >> 4) * 4); }
    const u16* ys = (const u16*)(p.ws + ys_off(n));
    gemm_tile<128, 4, 2>(y, [&](int r) { return ys + (size_t)(mt * BM + r) * 512; }, (const u16*)(wt + WT_WB) + (size_t)(n * 1024 + nt * 128) * 512, 512, 512, lds, tid);
#pragma unroll
    for (int a = 0; a < 4; ++a)
#pragma unroll
      for (int b = 0; b < 4; ++b) {
        const unsigned gw = g8[a][b];
        m[a][b][0] += (float)(gw & 255u) * y[a][b][0]; m[a][b][1] += (float)((gw >> 8) & 255u) * y[a][b][1];
        m[a][b][2] += (float)((gw >> 16) & 255u) * y[a][b][2]; m[a][b][3] += (float)(gw >> 24) * y[a][b][3];
      }
  }
  u16* M = (u16*)(p.ws + OFF_M);
#pragma unroll
  for (int mi = 0; mi < 4; ++mi) { const int row = mt * BM + wm * 64 + mi * 16 + (lane & 15);
#pragma unroll
    for (int ni = 0; ni < 4; ++ni) st4(M + (size_t)row * 1024 + nt * 128 + wn * 64 + ni * 16 + (lane >> 4) * 4, m[ni][mi][0] * (1.f / 255.f), m[ni][mi][1] * (1.f / 255.f), m[ni][mi][2] * (1.f / 255.f), m[ni][mi][3] * (1.f / 255.f)); }
}
DEVI void phase5(CPR p, int l, char* lds) {
  { const int ns = xcd_slots(NLAT / BM, 8); for (int it = blockIdx.x; it < ns; it += gridDim.x) { int mt, nt; if (xcd_tile(it, NLAT / BM, 8, mt, nt)) p5_item128(p, l, mt, nt, lds); } }
  if (l == 0) for (int it = blockIdx.x; it < 2 * 16; it += gridDim.x) p5_item64(p, l, (NLAT / BM) * 16 + it, lds);
  if (l == 0 && gridDim.x == 256 && blockIdx.x >= 32) { __syncthreads(); conv_run_part(0, 48, [&](int d) { return moe_desc(p, 0, d); }, lds, (int)blockIdx.x - 32, 224); }
}

DEVI void p6_item(CPR p, int l, int item, char* lds) {
  const int tid = TID(), lane = tid & 63, wave = __builtin_amdgcn_readfirstlane(tid >> 6), wr = wave >> 2, wc = wave & 3;
  const int mt = item >> 2, nt2 = item & 3;
  const u16* M = (const u16*)(p.ws + OFF_M) + (size_t)mt * BM * 1024;
  f32x4 acc[2][2][4][2];
#pragma unroll
  for (int a = 0; a < 2; ++a)
#pragma unroll
    for (int b = 0; b < 2; ++b)
#pragma unroll
      for (int c = 0; c < 4; ++c) { acc[a][b][c][0] = f32x4{0, 0, 0, 0}; acc[a][b][c][1] = f32x4{0, 0, 0, 0}; }
  gemm256<false, 0>(acc, (const u16*)(p.ws + OFF_WT + (size_t)l * WT_LAYER + WT_WO) + (size_t)nt2 * 256 * 1024, 1024, M, [&](int r) { return r * 1024; }, 1024, lds, tid);
  const float* mods = (const float*)(p.ws + OFF_MODS);
#pragma unroll
  for (int bj = 0; bj < 2; ++bj)
#pragma unroll
    for (int n = 0; n < 2; ++n) {
      const int row = mt * BM + bj * 128 + wc * 32 + n * 16 + (lane & 15); const bool lat = row < NLAT; const int ridx = lat ? (row >> 13) : 2;
      const float* g1 = mods + (size_t)(l * 3 + ridx) * 6144 + 2048;
      const float* src; float* dst;
      if (lat) { src = (l == 0 ? p.in[I_X] : p.out) + (size_t)row * 1024; dst = p.out + (size_t)row * 1024; }
      else { src = (l == 0 ? p.in[I_CTX] : (const float*)(p.ws + OFF_XC)) + (size_t)(row - NLAT) * 1024; dst = (float*)(p.ws + OFF_XC) + (size_t)(row - NLAT) * 1024; }
#pragma unroll
      for (int ai = 0; ai < 2; ++ai)
#pragma unroll
        for (int m = 0; m < 4; ++m) { const int col = nt2 * 256 + ai * 128 + wr * 64 + m * 16 + (lane >> 4) * 4;
          float4 x = *(const float4*)(src + col), g = *(const float4*)(g1 + col);
          x.x += g.x * acc[ai][bj][m][n][0]; x.y += g.y * acc[ai][bj][m][n][1]; x.z += g.z * acc[ai][bj][m][n][2]; x.w += g.w * acc[ai][bj][m][n][3];
          *(float4*)(dst + col) = x; }
    }
}
DEVI void p6_ctx_item(CPR p, int l, int item, char* lds) {
  const int tid = TID(), lane = tid & 63, wave = tid >> 6, wm = wave >> 1, wn = wave & 1;
  const int mt = NLAT / BM + (item >> 4), dt = item & 15;
  const u16* M = (const u16*)(p.ws + OFF_M);
  f32x4 acc[2][4];
#pragma unroll
  for (int a = 0; a < 2; ++a)
#pragma unroll
    for (int b = 0; b < 4; ++b) acc[a][b] = f32x4{0, 0, 0, 0};
  gemm_tile<64, 4, 2, 3>(acc, [&](int r) { return M + (size_t)(mt * BM + r) * 1024; }, (const u16*)(p.ws + OFF_WT + (size_t)l * WT_LAYER + WT_WO) + (size_t)dt * 64 * 1024, 1024, 1024, lds, tid);
  const float* g1 = (const float*)(p.ws + OFF_MODS) + (size_t)(l * 3 + 2) * 6144 + 2048;
#pragma unroll
  for (int mi = 0; mi < 4; ++mi) { const int row = mt * BM + wm * 64 + mi * 16 + (lane & 15);
    const float* src = (l == 0 ? p.in[I_CTX] : (const float*)(p.ws + OFF_XC)) + (size_t)(row - NLAT) * 1024; float* dst = (float*)(p.ws + OFF_XC) + (size_t)(row - NLAT) * 1024;
#pragma unroll
    for (int ni = 0; ni < 2; ++ni) { const int col = dt * 64 + wn * 32 + ni * 16 + (lane >> 4) * 4;
      float4 x = *(const float4*)(src + col), g = *(const float4*)(g1 + col);
      x.x += g.x * acc[ni][mi][0]; x.y += g.y * acc[ni][mi][1]; x.z += g.z * acc[ni][mi][2]; x.w += g.w * acc[ni][mi][3];
      *(float4*)(dst + col) = x; } }
}

DEVI void phase7(CPR p, int l, char* lds) {
  const int tid = TID(), lane = tid & 63, wave = tid >> 6;
  const float* mods = (const float*)(p.ws + OFF_MODS);
  u16* H = (u16*)(p.ws + OFF_H);
  int* cnt = (int*)(p.ws + OFF_CNT) + l * 16; int* list = (int*)(p.ws + OFF_LIST); float* tokw = (float*)(p.ws + OFF_TOKW);
  const float* rb = p.in[I_RB];
  const int nrows = (l == 0) ? NROW : NLAT;
  const int rpb = (((nrows + (int)gridDim.x - 1) / (int)gridDim.x) + 1) & ~1;
  const int row_lo = blockIdx.x * rpb, row_hi = (row_lo + rpb < nrows) ? row_lo + rpb : nrows;
  float* rwl = (float*)lds;
  int* sel = (int*)(lds + 65536);
  {
    const float4* src = (const float4*)(p.ws + OFF_RWT);
#pragma unroll
    for (int i = 0; i < 8; ++i) ((float4*)rwl)[tid + NTHR * i] = src[tid + NTHR * i];
  }
  int* rctr = (int*)(lds + 65536 + 2048);
  if (tid == 0) *rctr = 0;
  __syncthreads();
  if (!(l == 0 && gridDim.x == 256)) conv_run_w(48, 48 * 128, [&](int d) { return moe_desc(p, l, d); }, lds + 69632, 4, 4);
  const int wave_u = __builtin_amdgcn_readfirstlane(wave);
  auto rowsrc = [&](int row) { return row < NLAT ? p.out + (size_t)row * 1024 : (const float*)(p.ws + OFF_XC) + (size_t)(row - NLAT) * 1024; };
  float4 v[2][4], vn[2][4], ngv[4], shv[4], scv[4]; int cur_ridx = -1;
  auto claim = [&]() { int r = 0; if (lane == 0) r = atomicAdd(rctr, 2); return row_lo + __builtin_amdgcn_readfirstlane(r); };
  int row = claim();
  if (row < row_hi) {
#pragma unroll
    for (int j = 0; j < 4; ++j) { v[0][j] = *(const float4*)(rowsrc(row) + lane * 4 + 256 * j); v[1][j] = *(const float4*)(rowsrc(row + 1 < row_hi ? row + 1 : row) + lane * 4 + 256 * j);
      ngv[j] = *(const float4*)(p.in[I_N2G] + l * 1024 + lane * 4 + 256 * j); }
  }
  while (row < row_hi) {
    const bool lat = row < NLAT; const int ridx = lat ? (row >> 13) : 2;
    const bool valid1 = row + 1 < row_hi;
    const int rown = claim();
    if (rown < row_hi) {
#pragma unroll
      for (int j = 0; j < 4; ++j) { vn[0][j] = *(const float4*)(rowsrc(rown) + lane * 4 + 256 * j); vn[1][j] = *(const float4*)(rowsrc(rown + 1 < row_hi ? rown + 1 : rown) + lane * 4 + 256 * j); }
    }
    if (ridx != cur_ridx) { cur_ridx = ridx; const float* md = mods + (size_t)(l * 3 + ridx) * 6144;
#pragma unroll
      for (int j = 0; j < 4; ++j) { shv[j] = *(const float4*)(md + 3072 + lane * 4 + 256 * j); scv[j] = *(const float4*)(md + 4096 + lane * 4 + 256 * j); } }
    float ss[2];
#pragma unroll
    for (int u = 0; u < 2; ++u) { ss[u] = 0.f;
#pragma unroll
      for (int j = 0; j < 4; ++j) ss[u] += v[u][j].x * v[u][j].x + v[u][j].y * v[u][j].y + v[u][j].z * v[u][j].z + v[u][j].w * v[u][j].w; }
#pragma unroll
    for (int o = 1; o < 64; o <<= 1) { const float t0 = shx(ss[0], o), t1 = shx(ss[1], o); ss[0] += t0; ss[1] += t1; }
#pragma unroll
    for (int u = 0; u < 2; ++u) {
      const float rs = rsqrtf(ss[u] * (1.f / 1024.f) + EPS);
#pragma unroll
      for (int j = 0; j < 4; ++j) {
        const int k = lane * 4 + 256 * j;
        const float4 g = ngv[j], sh = shv[j], sc = scv[j];
        v[u][j].x = v[u][j].x * rs * g.x * (1.f + sc.x) + sh.x; v[u][j].y = v[u][j].y * rs * g.y * (1.f + sc.y) + sh.y;
        v[u][j].z = v[u][j].z * rs * g.z * (1.f + sc.z) + sh.z; v[u][j].w = v[u][j].w * rs * g.w * (1.f + sc.w) + sh.w;
        if (u == 0 || valid1) st4(H + (size_t)(row + u) * 1024 + k, v[u][j].x, v[u][j].y, v[u][j].z, v[u][j].w);
      }
    }
    float pl[2][16];
#pragma unroll
    for (int e = 0; e < 16; ++e) {
      float a0 = 0.f, a1 = 0.f;
#pragma unroll
      for (int j = 0; j < 4; ++j) { const float4 w = *(const float4*)(rwl + e * 1024 + lane * 4 + 256 * j);
        a0 += v[0][j].x * w.x + v[0][j].y * w.y + v[0][j].z * w.z + v[0][j].w * w.w; a1 += v[1][j].x * w.x + v[1][j].y * w.y + v[1][j].z * w.z + v[1][j].w * w.w; }
      pl[0][e] = a0; pl[1][e] = a1;
    }
    float w8[2][8], w4[2][4], w2[2][2], w1[2];
    { const bool up = (lane & 32) != 0;
#pragma unroll
      for (int i = 0; i < 8; ++i)
#pragma unroll
        for (int u = 0; u < 2; ++u) { const float snd = up ? pl[u][i] : pl[u][8 + i], kp = up ? pl[u][8 + i] : pl[u][i]; w8[u][i] = kp + shx(snd, 32); } }
    { const bool up = (lane & 16) != 0;
#pragma unroll
      for (int i = 0; i < 4; ++i)
#pragma unroll
        for (int u = 0; u < 2; ++u) { const float snd = up ? w8[u][i] : w8[u][4 + i], kp = up ? w8[u][4 + i] : w8[u][i]; w4[u][i] = kp + shx(snd, 16); } }
    { const bool up = (lane & 8) != 0;
#pragma unroll
      for (int i = 0; i < 2; ++i)
#pragma unroll
        for (int u = 0; u < 2; ++u) { const float snd = up ? w4[u][i] : w4[u][2 + i], kp = up ? w4[u][2 + i] : w4[u][i]; w2[u][i] = kp + shx(snd, 8); } }
    { const bool up = (lane & 4) != 0;
#pragma unroll
      for (int u = 0; u < 2; ++u) { const float snd = up ? w2[u][0] : w2[u][1], kp = up ? w2[u][1] : w2[u][0]; w1[u] = kp + shx(snd, 4); } }
    { const float t0 = shx(w1[0], 2), t1 = shx(w1[1], 2); w1[0] += t0; w1[1] += t1; }
    { const float t0 = shx(w1[0], 1), t1 = shx(w1[1], 1); w1[0] += t0; w1[1] += t1; }
#pragma unroll
    for (int u = 0; u < 2; ++u) {
      const float sg = 1.f / (1.f + expf(-w1[u]));
      float sc_[16], bi[16];
#pragma unroll
      for (int e = 0; e < 16; ++e) { sc_[e] = shl_(sg, 4 * e); bi[e] = sc_[e] + rb[e]; }
      float best_gs = -3.0e38f; int e1 = 0, e2 = 1; float s1 = 0.f, s2 = 0.f;
#pragma unroll
      for (int g = 0; g < 4; ++g) {
        const float a = bi[4 * g], b = bi[4 * g + 1], c = bi[4 * g + 2], d = bi[4 * g + 3];
        const float h1 = fmaxf(a, b), l1 = fminf(a, b), h2 = fmaxf(c, d), l2 = fminf(c, d);
        const float m1 = fmaxf(h1, h2), m2 = fmaxf(fminf(h1, h2), fmaxf(l1, l2));
        const float gs = m1 + m2;
        int i1 = 0; float v1 = a;
        if (b > v1) { v1 = b; i1 = 1; } if (c > v1) { v1 = c; i1 = 2; } if (d > v1) { v1 = d; i1 = 3; }
        int i2 = -1; float v2 = -3.0e38f;
        if (i1 != 0 && a > v2) { v2 = a; i2 = 0; } if (i1 != 1 && b > v2) { v2 = b; i2 = 1; } if (i1 != 2 && c > v2) { v2 = c; i2 = 2; } if (i1 != 3 && d > v2) { v2 = d; i2 = 3; }
        const float sa = sc_[4 * g], sb = sc_[4 * g + 1], scc = sc_[4 * g + 2], sd = sc_[4 * g + 3];
        const float t1 = i1 == 0 ? sa : (i1 == 1 ? sb : (i1 == 2 ? scc : sd));
        const float t2 = i2 == 0 ? sa : (i2 == 1 ? sb : (i2 == 2 ? scc : sd));
        if (gs > best_gs) { best_gs = gs; e1 = 4 * g + i1; e2 = 4 * g + i2; s1 = t1; s2 = t2; }
      }
      if (lane == 0 && (u == 0 || valid1)) {
        const float inv = 1.f / (s1 + s2); const int r_ = row + u;
        sel[(r_ - row_lo) * 2] = e1; sel[(r_ - row_lo) * 2 + 1] = e2;
        tokw[r_ * 2] = s1 * inv; tokw[r_ * 2 + 1] = s2 * inv;
      }
    }
#pragma unroll
    for (int u = 0; u < 2; ++u)
#pragma unroll
      for (int j = 0; j < 4; ++j) v[u][j] = vn[u][j];
    row = rown;
  }
  __syncthreads();
  if (tid < 16) {
    const int e = tid, n = row_hi - row_lo; int c = 0;
    for (int i = 0; i < 2 * n; ++i) c += (sel[i] == e) ? 1 : 0;
    if (c > 0) {
      int pos = atomicAdd(&cnt[e], c);
      int* dst = list + (size_t)e * LCAP;
      for (int i = 0; i < 2 * n; ++i) if (sel[i] == e) dst[pos++] = (row_lo + (i >> 1)) * 2 + (i & 1);
    }
  }
  __syncthreads();
}

struct ExpTile { int e, mt, rowbase, count, ntiles; };
DEVI ExpTile exp_find(const int* cnt, int tile) {
  ExpTile r; r.e = 0; r.mt = 0; r.rowbase = 0; r.count = 0; int tacc = 0, racc = 0;
#pragma unroll
  for (int i = 0; i < 16; ++i) { const int c = cnt[i]; const int n = (c + BM - 1) / BM;
    if (tile >= tacc && tile < tacc + n) { r.e = i; r.mt = tile - tacc; r.rowbase = racc; r.count = c; }
    tacc += n; racc += c; }
  r.ntiles = tacc;
  r.e = __builtin_amdgcn_readfirstlane(r.e); r.mt = __builtin_amdgcn_readfirstlane(r.mt); r.rowbase = __builtin_amdgcn_readfirstlane(r.rowbase); r.count = __builtin_amdgcn_readfirstlane(r.count); r.ntiles = __builtin_amdgcn_readfirstlane(r.ntiles);
  return r;
}
DEVI bool moe_split(int ntot, int& nfull) { const int G = gridDim.x, rem = ntot % G; const bool sp = rem > 0 && ntot > G && rem * 4 <= 2 * G; nfull = sp ? ntot - rem : ntot; return sp; }
DEVI void p8_piece(CPR p, int l, int item, int g, char* lds) {
  const int tid = TID(), lane = tid & 63, wave = tid >> 6;
  const int* cnt = (const int*)(p.ws + OFF_CNT) + l * 16; const int* list = (const int*)(p.ws + OFF_LIST);
  const u16* H = (const u16*)(p.ws + OFF_H); u16* HE = (u16*)(p.ws + OFF_HEXP);
  const ExpTile et = exp_find(cnt, item >> 2); const int nt2 = item & 3;
  const int* lst = list + (size_t)et.e * LCAP;
  f32x4 acc[4][2];
#pragma unroll
  for (int a = 0; a < 4; ++a) { acc[a][0] = f32x4{0, 0, 0, 0}; acc[a][1] = f32x4{0, 0, 0, 0}; }
  gemm_tile<64, 8, 1, 3>(acc, [&](int r) { int s = et.mt * BM + r; s = s < et.count ? s : 0; return H + (size_t)(lst[s] >> 1) * 1024; },
                         (const u16*)(p.ws + OFF_MOEW13) + (size_t)(et.e * 1024 + nt2 * 256 + g * 64) * 1024, 1024, 1024, lds, tid);
#pragma unroll
  for (int mi = 0; mi < 2; ++mi) { const int s = et.mt * BM + wave * 32 + mi * 16 + (lane & 15);
    if (s < et.count) {
#pragma unroll
      for (int ni = 0; ni < 2; ++ni) { float hv[4];
#pragma unroll
        for (int r = 0; r < 4; ++r) { const float a = acc[ni][mi][r], b = acc[ni + 2][mi][r]; hv[r] = a * sigmoidf_(a) * b; }
        st4(HE + (size_t)(et.rowbase + s) * 512 + nt2 * 128 + g * 32 + ni * 16 + (lane >> 4) * 4, hv[0], hv[1], hv[2], hv[3]); }
    } }
}
DEVI void p9_piece(CPR p, int l, int item, int g, char* lds) {
  const int tid = TID(), lane = tid & 63, wave = tid >> 6;
  const int* cnt = (const int*)(p.ws + OFF_CNT) + l * 16; const int* list = (const int*)(p.ws + OFF_LIST);
  const u16* HE = (const u16*)(p.ws + OFF_HEXP); u16* YB = (u16*)(p.ws + OFF_YBUF);
  const ExpTile et = exp_find(cnt, item >> 2); const int nt2 = item & 3;
  const int* lst = list + (size_t)et.e * LCAP;
  f32x4 acc[4][2];
#pragma unroll
  for (int a = 0; a < 4; ++a) { acc[a][0] = f32x4{0, 0, 0, 0}; acc[a][1] = f32x4{0, 0, 0, 0}; }
  gemm_tile<64, 8, 1, 3>(acc, [&](int r) { return HE + (size_t)(et.rowbase + et.mt * BM + r) * 512; },
                         (const u16*)(p.ws + OFF_MOEW2) + (size_t)(et.e * 1024 + nt2 * 256 + g * 64) * 512, 512, 512, lds, tid);
#pragma unroll
  for (int mi = 0; mi < 2; ++mi) { const int s = et.mt * BM + wave * 32 + mi * 16 + (lane & 15);
    if (s < et.count) { const int a = lst[s];
#pragma unroll
      for (int ni = 0; ni < 4; ++ni) st4(YB + (size_t)a * 1024 + nt2 * 256 + g * 64 + ni * 16 + (lane >> 4) * 4, acc[ni][mi][0], acc[ni][mi][1], acc[ni][mi][2], acc[ni][mi][3]); }
  }
}
DEVI void phase8(CPR p, int l, char* lds) {
  const int tid = TID(), lane = tid & 63, wave = __builtin_amdgcn_readfirstlane(tid >> 6), wr = wave >> 2, wc = wave & 3;
  const int* cnt = (const int*)(p.ws + OFF_CNT) + l * 16; const int* list = (const int*)(p.ws + OFF_LIST);
  const u16* H = (const u16*)(p.ws + OFF_H); u16* HE = (u16*)(p.ws + OFF_HEXP);
  const int ntot = exp_find(cnt, -1).ntiles * 4; int nfull; const bool split = moe_split(ntot, nfull);
  if (split) for (int pc = blockIdx.x; pc < ((ntot - nfull + 7) >> 3) * 32; pc += gridDim.x) { const int io = ((pc >> 5) << 3) + (pc & 7);
    if (io < ntot - nfull) p8_piece(p, l, nfull + io, (pc >> 3) & 3, lds); }
  for (int item = blockIdx.x; item < nfull; item += gridDim.x) {
    const ExpTile et = exp_find(cnt, item >> 2); const int nt2 = item & 3;
    const int* lst = list + (size_t)et.e * LCAP;
    f32x4 acc[2][2][4][2];
#pragma unroll
    for (int a = 0; a < 2; ++a)
#pragma unroll
      for (int b = 0; b < 2; ++b)
#pragma unroll
        for (int c = 0; c < 4; ++c) { acc[a][b][c][0] = f32x4{0, 0, 0, 0}; acc[a][b][c][1] = f32x4{0, 0, 0, 0}; }
    gemm256<true, 0>(acc, (const u16*)(p.ws + OFF_MOEW13) + (size_t)(et.e * 1024 + nt2 * 256) * 1024, 1024, H,
            [&](int r) { int s = et.mt * BM + r; s = s < et.count ? s : 0; return (lst[s] >> 1) * 1024; }, 1024, lds, tid);
#pragma unroll
    for (int bj = 0; bj < 2; ++bj)
#pragma unroll
      for (int n = 0; n < 2; ++n) { const int s = et.mt * BM + bj * 128 + wc * 32 + n * 16 + (lane & 15);
        if (s < et.count) {
#pragma unroll
          for (int ai = 0; ai < 2; ++ai)
#pragma unroll
            for (int m = 0; m < 2; ++m) { float hv[4];
#pragma unroll
              for (int r = 0; r < 4; ++r) { const float a = acc[ai][bj][m][n][r], b = acc[ai][bj][m + 2][n][r]; hv[r] = a * sigmoidf_(a) * b; }
              st4(HE + (size_t)(et.rowbase + s) * 512 + nt2 * 128 + ai * 64 + wr * 32 + m * 16 + (lane >> 4) * 4, hv[0], hv[1], hv[2], hv[3]); }
        } }
  }
}
DEVI void phase9(CPR p, int l, char* lds) {
  const int tid = TID(), lane = tid & 63, wave = __builtin_amdgcn_readfirstlane(tid >> 6), wr = wave >> 2, wc = wave & 3;
  const int* cnt = (const int*)(p.ws + OFF_CNT) + l * 16; const int* list = (const int*)(p.ws + OFF_LIST);
  const u16* HE = (const u16*)(p.ws + OFF_HEXP); u16* YB = (u16*)(p.ws + OFF_YBUF);
  const int ntot = exp_find(cnt, -1).ntiles * 4; int nfull; const bool split = moe_split(ntot, nfull);
  if (split) for (int pc = blockIdx.x; pc < ((ntot - nfull + 7) >> 3) * 32; pc += gridDim.x) { const int io = ((pc >> 5) << 3) + (pc & 7);
    if (io < ntot - nfull) p9_piece(p, l, nfull + io, (pc >> 3) & 3, lds); }
  for (int item = blockIdx.x; item < nfull; item += gridDim.x) {
    const ExpTile et = exp_find(cnt, item >> 2); const int nt2 = item & 3;
    const int* lst = list + (size_t)et.e * LCAP;
    f32x4 acc[2][2][4][2];
#pragma unroll
    for (int a = 0; a < 2; ++a)
#pragma unroll
      for (int b = 0; b < 2; ++b)
#pragma unroll
        for (int c = 0; c < 4; ++c) { acc[a][b][c][0] = f32x4{0, 0, 0, 0}; acc[a][b][c][1] = f32x4{0, 0, 0, 0}; }
    gemm256<false, 0>(acc, (const u16*)(p.ws + OFF_MOEW2) + (size_t)(et.e * 1024 + nt2 * 256) * 512, 512, HE + (size_t)(et.rowbase + et.mt * BM) * 512,
            [&](int r) { return r * 512; }, 512, lds, tid);
#pragma unroll
    for (int bj = 0; bj < 2; ++bj)
#pragma unroll
      for (int n = 0; n < 2; ++n) { const int s = et.mt * BM + bj * 128 + wc * 32 + n * 16 + (lane & 15);
        if (s < et.count) { const int a = lst[s];
#pragma unroll
          for (int ai = 0; ai < 2; ++ai)
#pragma unroll
            for (int m = 0; m < 4; ++m) st4(YB + (size_t)a * 1024 + nt2 * 256 + ai * 128 + wr * 64 + m * 16 + (lane >> 4) * 4, acc[ai][bj][m][n][0], acc[ai][bj][m][n][1], acc[ai][bj][m][n][2], acc[ai][bj][m][n][3]); }
      }
  }
}

DEVI void run_stage(KPTR kp, int stage, char* lds) {
  asm volatile("" : "+s"(kp));
  CPR p = *kp;
  if (stage == 0) { phase0(p, lds); return; }
  if (stage == 19) { phase_final(p); return; }
  if (stage == 20) { const u16* buf = (const u16*)(p.ws + DUMP_OFF);
    for (size_t i = (size_t)blockIdx.x * NTHR + threadIdx.x; i < (size_t)NLAT * 1024; i += (size_t)gridDim.x * NTHR) { size_t row = i >> 10; int c = (int)(i & 1023) % DUMP_LD; p.out[i] = bf2f(buf[row * DUMP_LD + c]); }
    return; }
  const int l = (stage - 1) / 9, ph = (stage - 1) % 9 + 1;
  const int nM = (l == 0) ? NROW / BM : NLAT / BM;
  if (PH_ONLY && ph != PH_ONLY) return;
  switch (PH_ONLY ? PH_ONLY : ph) {
    case 1: phase1(p, l, lds); break;
    case 2: phase2(p, l, lds); phase3_tail(p, l, lds); break;
    case 3: break;
    case 4: phase4(p, l, lds); break;
    case 5: phase5(p, l, lds); break;
    case 6: for (int it = blockIdx.x; it < (NLAT / BM) * 4; it += gridDim.x) p6_item(p, l, it, lds);
      if (l == 0) for (int it = blockIdx.x; it < 32; it += gridDim.x) p6_ctx_item(p, l, it, lds);
      break;
    case 7: phase7(p, l, lds); break;
    case 8: phase8(p, l, lds); break;
    default: phase9(p, l, lds); break;
  }
}

#ifndef EXTRA_BARS
#define EXTRA_BARS 0
#endif
#ifndef REP_ATTN
#define REP_ATTN 0
#endif
#ifndef USE_CG_SYNC
#define USE_CG_SYNC 0
#endif
#ifndef REP_MASK
#define REP_MASK 0u
#endif
#if ONE_LAUNCH
#define XB_TMO      128
#define XB_XCNT(j)  (256  + 64 * (j))
#define XB_XSUB(j)  (1280 + 64 * (j))
#define XB_XGEN(j)  (2304 + 64 * (j))
#define XB_TOP      3328
#define XB_TOPGEN   3392
#define XCD_BAR_WORDS 3456
#define XB_SPIN_CAP (1u << 20)
DEVI unsigned xb_ld(unsigned* p)              { return __hip_atomic_load(p, __ATOMIC_RELAXED, __HIP_MEMORY_SCOPE_AGENT); }
DEVI unsigned xb_add(unsigned* p, unsigned v) { return __hip_atomic_fetch_add(p, v, __ATOMIC_RELAXED, __HIP_MEMORY_SCOPE_AGENT); }
DEVI unsigned xb_xcc_id() { return (unsigned)__builtin_amdgcn_s_getreg((3 << 11) | 20) & 0xFu; }
#define XB_SPIN(cond, bar) do { unsigned _sp = 0; while (cond) { __builtin_amdgcn_s_sleep(1); \
    if ((++_sp & 255u) == 0u) { if (xb_ld(&(bar)[XB_TMO])) break; if (_sp > XB_SPIN_CAP) { atomicAdd(&(bar)[XB_TMO], 1u); break; } } } } while (0)
DEVI void xcd_barrier_complete(unsigned* bar, unsigned x, unsigned& nloc, unsigned& nx) {
  const unsigned G = gridDim.x;
  unsigned sum, cnt, mine, sp = 0u;
  for (;;) {
    sum = 0u; cnt = 0u; mine = 0u;
#pragma unroll
    for (unsigned j = 0; j < 16; ++j) { const unsigned c = xb_ld(&bar[XB_XCNT(j)]); sum += c; cnt += (c > 0u) ? 1u : 0u; mine = (j == x) ? c : mine; }
    if (sum == G) break;
    __builtin_amdgcn_s_sleep(1);
    if ((++sp & 255u) == 0u) { if (xb_ld(&bar[XB_TMO])) break; if (sp > XB_SPIN_CAP) { atomicAdd(&bar[XB_TMO], 1u); break; } }
  }
  nloc = mine > 0u ? mine : 1u; nx = cnt > 0u ? cnt : 1u;
}
DEVI void xcd_barrier(unsigned* bar, unsigned x, volatile LAS unsigned* st) {
  asm volatile("s_waitcnt vmcnt(0)" ::: "memory");
  __syncthreads();
  if (TID() == 0) {
    __builtin_amdgcn_s_waitcnt(0);
    unsigned nloc = st[0], nx = st[1];
    if (nloc == 0u) { xcd_barrier_complete(bar, x, nloc, nx); st[0] = nloc; st[1] = nx; }
    const unsigned old = xb_add(&bar[XB_XSUB(x)], 1u);
    const unsigned gen = old / nloc;
    if (old + 1u == (gen + 1u) * nloc) {
      __builtin_amdgcn_fence(__ATOMIC_RELEASE, "agent");
      asm volatile("s_waitcnt vmcnt(0)" ::: "memory");
      const unsigned og = xb_add(&bar[XB_TOP], 1u);
      const unsigned tg = og / nx;
      if (og + 1u == (tg + 1u) * nx) xb_add(&bar[XB_TOPGEN], 1u);
      else XB_SPIN(xb_ld(&bar[XB_TOPGEN]) == tg, bar);
      __builtin_amdgcn_fence(__ATOMIC_ACQUIRE, "agent");
      xb_add(&bar[XB_XGEN(x)], 1u);
      asm volatile("s_waitcnt vmcnt(0)" ::: "memory");
    } else {
      XB_SPIN(xb_ld(&bar[XB_XGEN(x)]) == gen, bar);
      __builtin_amdgcn_fence(__ATOMIC_ACQUIRE, "agent");
      asm volatile("s_waitcnt vmcnt(0)" ::: "memory");
    }
  }
  __syncthreads();
}
__global__ void __launch_bounds__(NTHR, 2) mega_kernel(Params p_) {
  __shared__ __attribute__((aligned(16))) char lds[LDS_BYTES];
  cg::grid_group grid = cg::this_grid();
  unsigned* bar = (unsigned*)(((KPTR)__builtin_amdgcn_kernarg_segment_ptr())->ws + OFF_BAR);
  volatile LAS unsigned* st = (volatile LAS unsigned*)(lds + LDS_BYTES - 16);
  if (threadIdx.x == 0) { st[0] = 0u; st[1] = 0u; }
  tid_init();
  const unsigned xcc = xb_xcc_id();
  if (threadIdx.x == 0) (void)xb_add(&bar[XB_XCNT(xcc)], 1u);
#pragma unroll 1
  for (int stage = 0; stage < 20; ++stage) {
    run_stage((KPTR)__builtin_amdgcn_kernarg_segment_ptr(), stage, lds);
    if (stage == 0 && USE_CG_SYNC) grid.sync();
    else if (stage < 19 && stage % 9 != 2) { xcd_barrier(bar, xcc, st); for (int e = 0; e < EXTRA_BARS; ++e) xcd_barrier(bar, xcc, st); }
  }
}
#else
__global__ void __launch_bounds__(NTHR, 2) stage_kernel(Params p, int stage) {
  __shared__ __attribute__((aligned(16))) char lds[LDS_BYTES];
  tid_init();
  run_stage((KPTR)__builtin_amdgcn_kernarg_segment_ptr(), stage, lds);
}
#endif

extern "C" void kernel_launch(void* const* d_in, const int* in_sizes, int n_in, void* d_out, int out_size, void* d_ws, size_t ws_size, hipStream_t stream) {
  static int grid_blocks = 0;
  if (grid_blocks == 0) {
    if (n_in != 32 || ws_size < WS_END || out_size != NLAT * 1024) { fprintf(stderr, "kernel_launch: unexpected shapes (n_in %d, ws %zu need %zu, out %d)\n", n_in, ws_size, (size_t)WS_END, out_size); grid_blocks = -1; return; }
    int dev = 0, cus = 0, per_cu = 0;
    hipGetDevice(&dev);
    hipDeviceGetAttribute(&cus, hipDeviceAttributeMultiprocessorCount, dev);
#if ONE_LAUNCH
    hipOccupancyMaxActiveBlocksPerMultiprocessor(&per_cu, mega_kernel, NTHR, 0);
#else
    hipOccupancyMaxActiveBlocksPerMultiprocessor(&per_cu, stage_kernel, NTHR, 0);
#endif
    if (per_cu < 1) per_cu = 1;
    if (per_cu > 1) per_cu = 1;
    grid_blocks = cus * per_cu;
  }
  if (grid_blocks < 0) return;
  Params p{};
  for (int i = 0; i < 32; ++i) p.in[i] = (const float*)d_in[i];
  p.out = (float*)d_out; p.ws = (char*)d_ws;
#if ONE_LAUNCH
  hipMemsetAsync((char*)d_ws + OFF_BAR, 0, 16384, stream);
  void* args[] = {&p};
  hipError_t e = hipLaunchCooperativeKernel((void*)mega_kernel, dim3(grid_blocks), dim3(NTHR), args, 0, stream);
  if (e != hipSuccess) fprintf(stderr, "cooperative launch failed: %s (grid %d)\n", hipGetErrorString(e), grid_blocks);
#else
  for (int s = 0; s < STOP_STAGE; ++s) hipLaunchKernelGGL(stage_kernel, dim3(grid_blocks), dim3(NTHR), 0, stream, p, s);
  if (STOP_STAGE < 20) hipLaunchKernelGGL(stage_kernel, dim3(grid_blocks), dim3(NTHR), 0, stream, p, 20);
#endif
}
```
